# Optimizing an MI355X kernel written in HIP

```python
import jax, jax.numpy as jnp
from jax import lax
import numpy as np

D_MODEL = 2048
BATCH = 16
SEQ = 256
DEPTH = 4
DEC_BATCH = 4
DEC_SEQ = 2048
PAST_LEN = 256

GRID_W = 64
D_MIX = D_MODEL
D_FOURIER = D_MIX // 4
N_FOURIER_GROUPS = 4
FOURIER_GROUP = D_FOURIER // N_FOURIER_GROUPS
D_DELTA = D_MIX - D_FOURIER
HEAD_DIM = 128
N_HEADS = D_DELTA // HEAD_DIM
N_DIR = 2
CONV_K = 3
CHUNK = 64
D_IN = 2 * D_FOURIER + 4 * D_DELTA + 2 * N_DIR * N_HEADS
EPS = 1e-6

kernel_name = "hybrid_fourier_gdn_diffusion_step"


def _rms_norm(x, w):
    xf = x.astype(jnp.float32)
    y = xf * lax.rsqrt(jnp.mean(xf * xf, axis=-1, keepdims=True) + EPS)
    return (y * w.astype(jnp.float32)).astype(x.dtype)


def _l2norm(x):
    return x * lax.rsqrt(jnp.sum(x * x, axis=-1, keepdims=True) + EPS)


def _short_conv(x, w):
    pad = CONV_K // 2
    l = x.shape[1]
    xp = jnp.pad(x, ((0, 0), (pad, pad), (0, 0)))
    y = xp[:, 0:l] * w[0]
    for j in range(1, CONV_K):
        y = y + xp[:, j:j + l] * w[j]
    return jax.nn.silu(y)


def _fourier_mix(u, grid):
    b, l, _ = u.shape
    uf = u.astype(jnp.float32)
    if grid:
        rows = l // GRID_W
        uf = uf.reshape(b, rows, GRID_W, N_FOURIER_GROUPS, FOURIER_GROUP)
        y = jnp.fft.fftn(uf, axes=(1, 2, 4), norm="ortho").real
    else:
        uf = uf.reshape(b, l, N_FOURIER_GROUPS, FOURIER_GROUP)
        y = jnp.fft.fftn(uf, axes=(1, 3), norm="ortho").real
    return y.reshape(b, l, D_FOURIER).astype(u.dtype)


def _chunk_gated_delta(q, k, v, log_g, beta, s0):
    b, l, h, _ = q.shape
    dv = v.shape[-1]
    n = l // CHUNK

    def heads_first(t):
        t = t.reshape((b, n, CHUNK, h) + t.shape[3:])
        return jnp.moveaxis(t, 3, 1)

    q, k, v, log_g, beta = (heads_first(t) for t in (q, k, v, log_g, beta))
    g = jnp.cumsum(log_g, axis=-1)
    idx = jnp.arange(CHUNK)
    incl = idx[:, None] >= idx[None, :]
    strict = idx[:, None] > idx[None, :]
    diff = g[..., :, None] - g[..., None, :]
    decay = jnp.where(incl, jnp.exp(jnp.where(incl, diff, 0.0)), 0.0)
    kb = k * beta[..., None]
    vb = v * beta[..., None]
    lmat = jnp.where(strict, jnp.einsum("bhncd,bhnsd->bhncs", kb, k) * decay, 0.0)
    eye = jnp.eye(CHUNK, dtype=q.dtype)
    a = lmat + eye
    t_inv = lax.linalg.triangular_solve(a, jnp.broadcast_to(eye, a.shape),
                                        left_side=True, lower=True)
    u = jnp.einsum("bhncs,bhnsd->bhncd", t_inv, vb)
    w = jnp.einsum("bhncs,bhnsd->bhncd", t_inv, kb * jnp.exp(g)[..., None])
    attn = jnp.where(incl, jnp.einsum("bhncd,bhnsd->bhncs", q, k) * decay, 0.0)
    qg = q * jnp.exp(g)[..., None]
    g_last = g[..., -1]
    kd = k * jnp.exp(g_last[..., None] - g)[..., None]
    xs = tuple(jnp.moveaxis(t, 2, 0) for t in (u, w, attn, qg, kd, g_last))

    def step(s, inp):
        u_i, w_i, a_i, qg_i, kd_i, gl_i = inp
        v_new = u_i - jnp.einsum("bhcd,bhde->bhce", w_i, s)
        o_i = (jnp.einsum("bhcd,bhde->bhce", qg_i, s)
               + jnp.einsum("bhcs,bhse->bhce", a_i, v_new))
        s = s * jnp.exp(gl_i)[..., None, None] + jnp.einsum("bhcd,bhce->bhde", kd_i, v_new)
        return s, o_i

    s_fin, o = lax.scan(step, s0, xs)
    o = jnp.transpose(o, (1, 0, 3, 2, 4)).reshape(b, l, h, dv)
    return o, s_fin


def _layer(x, mod, norm_w, w_in, conv_w, a_log, dt_bias, gnorm_w, w_out, s0, grid):
    bsz, l, _ = x.shape
    shift, scale, gate = jnp.split(mod, 3, axis=-1)
    h = _rms_norm(x, norm_w) * (1.0 + scale[:, None]) + shift[:, None]
    proj = h @ w_in
    u_f, z_f, qkv, z_d, ab = jnp.split(
        proj, [D_FOURIER, 2 * D_FOURIER, 2 * D_FOURIER + 3 * D_DELTA,
               2 * D_FOURIER + 4 * D_DELTA], axis=-1)
    y_f = _fourier_mix(u_f, grid) * jax.nn.silu(z_f)
    qkv = _short_conv(qkv, conv_w).astype(jnp.float32)
    q, k, v = jnp.split(qkv, 3, axis=-1)
    q = _l2norm(q.reshape(bsz, l, N_HEADS, HEAD_DIM)) * (HEAD_DIM ** -0.5)
    k = _l2norm(k.reshape(bsz, l, N_HEADS, HEAD_DIM))
    v = v.reshape(bsz, l, N_HEADS, HEAD_DIM)
    ab = ab.astype(jnp.float32).reshape(bsz, l, 2, N_DIR, N_HEADS)
    log_g = -jnp.exp(a_log.astype(jnp.float32)) * jax.nn.softplus(
        ab[:, :, 0] + dt_bias.astype(jnp.float32))
    beta = jax.nn.sigmoid(ab[:, :, 1])
    s0 = s0.astype(jnp.float32)
    o_fw, s_fw = _chunk_gated_delta(q, k, v, log_g[:, :, 0], beta[:, :, 0], s0[:, 0])
    flip = lambda t: jnp.flip(t, axis=1)
    o_bw, s_bw = _chunk_gated_delta(flip(q), flip(k), flip(v), flip(log_g[:, :, 1]),
                                    flip(beta[:, :, 1]), s0[:, 1])
    o = (o_fw + flip(o_bw)).astype(x.dtype)
    y_d = _rms_norm(o, gnorm_w).reshape(bsz, l, D_DELTA) * jax.nn.silu(z_d)
    y = jnp.concatenate([y_f, y_d], axis=-1) @ w_out
    return x + gate[:, None] * y, jnp.stack([s_fw, s_bw], axis=1)


def setup_inputs(seed: int = 0) -> dict:
    key = jax.random.key(seed)
    ks = jax.random.split(key, 16)
    f32 = jnp.float32
    x_prompt = jax.random.normal(ks[0], (BATCH, SEQ, D_MODEL), f32)
    x_sample = jax.random.normal(ks[1], (DEC_BATCH, DEC_SEQ, D_MODEL), f32)
    state_ctx = 0.1 * jax.random.normal(
        ks[2], (DEC_BATCH, DEPTH, N_DIR, N_HEADS, HEAD_DIM, HEAD_DIM), f32)
    c = jax.random.normal(ks[3], (DEC_BATCH, D_MODEL), f32)
    c_ctx = jax.random.normal(ks[4], (D_MODEL,), f32)
    norm_w = 1.0 + 0.02 * jax.random.normal(ks[5], (DEPTH, D_MODEL), f32)
    w_mod = 0.5 * D_MODEL ** -0.5 * jax.random.normal(ks[6], (DEPTH, D_MODEL, 3 * D_MODEL), f32)
    b_mod = 0.02 * jax.random.normal(ks[7], (DEPTH, 3 * D_MODEL), f32)
    w_in = D_MODEL ** -0.5 * jax.random.normal(ks[8], (DEPTH, D_MODEL, D_IN), f32)
    conv_w = CONV_K ** -0.5 * jax.random.normal(ks[9], (DEPTH, CONV_K, 3 * D_DELTA), f32)
    a_log = jnp.log(jax.random.uniform(ks[10], (DEPTH, N_DIR, N_HEADS), f32, 1.0, 16.0))
    dt_bias = 0.5 * jax.random.normal(ks[11], (DEPTH, N_DIR, N_HEADS), f32)
    gnorm_w = 1.0 + 0.02 * jax.random.normal(ks[12], (DEPTH, HEAD_DIM), f32)
    w_out = D_MIX ** -0.5 * jax.random.normal(ks[13], (DEPTH, D_MIX, D_MODEL), f32)
    final_norm_w = 1.0 + 0.02 * jax.random.normal(ks[14], (D_MODEL,), f32)
    return {"x_prompt": x_prompt, "x_sample": x_sample, "state_ctx": state_ctx,
            "c": c, "c_ctx": c_ctx, "norm_w": norm_w, "w_mod": w_mod, "b_mod": b_mod,
            "w_in": w_in, "conv_w": conv_w, "a_log": a_log, "dt_bias": dt_bias,
            "gnorm_w": gnorm_w, "w_out": w_out, "final_norm_w": final_norm_w}


def reference(x_prompt, x_sample, state_ctx, c, c_ctx, norm_w, w_mod, b_mod, w_in,
              conv_w, a_log, dt_bias, gnorm_w, w_out, final_norm_w):
    xp = x_prompt
    xs = x_sample
    s_zero = jnp.zeros((x_prompt.shape[0], N_DIR, N_HEADS, HEAD_DIM, HEAD_DIM), jnp.float32)
    silu_ctx = jax.nn.silu(c_ctx)[None]
    silu_c = jax.nn.silu(c)
    states = []
    for i in range(DEPTH):
        mod_ctx = silu_ctx @ w_mod[i] + b_mod[i]
        mod_lat = silu_c @ w_mod[i] + b_mod[i]
        xp, s_new = _layer(xp, mod_ctx, norm_w[i], w_in[i], conv_w[i], a_log[i],
                           dt_bias[i], gnorm_w[i], w_out[i], s_zero, False)
        states.append(s_new)
        xs, _ = _layer(xs, mod_lat, norm_w[i], w_in[i], conv_w[i], a_log[i],
                       dt_bias[i], gnorm_w[i], w_out[i], state_ctx[:, i], True)
    y_prompt = _rms_norm(xp, final_norm_w)
    y_sample = _rms_norm(xs, final_norm_w)
    state_new = jnp.stack(states, axis=1).astype(x_prompt.dtype)
    return (y_prompt, y_sample, state_new)
```

```cpp
#include <hip/hip_runtime.h>
#include <hip/hip_cooperative_groups.h>
#include <cstdio>
namespace cg = cooperative_groups;

#ifndef PROBE_DUP
#define PROBE_DUP -1
#endif
#ifndef ONE_LAUNCH
#define ONE_LAUNCH 1
#endif

constexpr int D = 2048, NCTX = 4096, NLAT = 8192, MTOK = 12288, DIN = 7216, NPAD = 7424, NPROJ = 7168;
constexpr int DEPTH = 4, NH = 12, HD = 128, DD = 1536, DF = 512, NAB = 48;
constexpr int NTHREADS = 512, LDS_BYTES = 147456;
constexpr float EPS = 1e-6f;

typedef unsigned short bf16_t;
typedef short bf16x8 __attribute__((ext_vector_type(8)));
typedef float f32x4 __attribute__((ext_vector_type(4)));
typedef float f32x16 __attribute__((ext_vector_type(16)));
typedef float f32x2 __attribute__((ext_vector_type(2)));
typedef unsigned u32x4 __attribute__((ext_vector_type(4)));
typedef unsigned u32x2 __attribute__((ext_vector_type(2)));

typedef __bf16 bf16v2 __attribute__((ext_vector_type(2)));
__device__ __forceinline__ unsigned cvt_pk_bf16(float lo, float hi) { f32x2 v = {lo, hi}; bf16v2 b = __builtin_convertvector(v, bf16v2); return __builtin_bit_cast(unsigned, b); }
__device__ __forceinline__ float bf_lo(unsigned w) { return __uint_as_float(w << 16); }
__device__ __forceinline__ float bf_hi(unsigned w) { return __uint_as_float(w & 0xffff0000u); }
__device__ __forceinline__ float bf1(bf16_t b) { return __uint_as_float(((unsigned)b) << 16); }
__device__ __forceinline__ float silu_f(float x) { return x * __builtin_amdgcn_rcpf(1.0f + __expf(-x)); }
__device__ __forceinline__ float lshfl(float v, int src) { return __builtin_bit_cast(float, __builtin_amdgcn_ds_bpermute(src << 2, __builtin_bit_cast(int, v))); }
__device__ __forceinline__ float wave_sum(float v, int lane) {
#pragma unroll
    for (int o = 32; o >= 1; o >>= 1) v += lshfl(v, lane ^ o);
    return v;
}

__device__ __forceinline__ int opaque_tid(int wv) { int l; asm volatile("v_mbcnt_lo_u32_b32 %0, -1, 0\n\tv_mbcnt_hi_u32_b32 %0, -1, %0" : "=v"(l)); return wv * 64 + l; }
constexpr size_t WS_WINT = 0;
constexpr size_t WS_WOUTT = WS_WINT + (size_t)2 * NPAD * D * 2;
constexpr size_t WS_MOD = WS_WOUTT + (size_t)D * D * 2;
constexpr size_t WS_X = WS_MOD + (size_t)DEPTH * 5 * 6144 * 4;
constexpr size_t WS_H = WS_X + (size_t)MTOK * D * 4;
constexpr size_t WS_PROJ = WS_H + (size_t)MTOK * D * 2;
constexpr size_t WS_AB = WS_PROJ + (size_t)MTOK * NPROJ * 2;
constexpr size_t WS_O = WS_AB + (size_t)MTOK * NAB * 4;
constexpr size_t WS_Z = WS_O + (size_t)2 * MTOK * DD * 2;
constexpr size_t WS_FT = WS_Z + (size_t)16 * 64 * 128 * 64 * 2;
constexpr int NCI = 192 * NH * 2;
constexpr size_t SCAN_STRIDE = 73728;
constexpr size_t WS_SCAN = WS_FT + (size_t)22784 * 16;
constexpr size_t WS_EG = WS_SCAN + (size_t)NCI * SCAN_STRIDE;
constexpr size_t WS_YF = WS_EG + (size_t)NCI * 4;
constexpr size_t WS_BAR = WS_YF + (size_t)MTOK * DF * 2;
constexpr size_t WS_END = WS_BAR + 16384;

struct Args {
    const float* x_prompt; const float* x_sample; const float* state_ctx; const float* c; const float* c_ctx; const float* norm_w; const float* w_mod; const float* b_mod;
    const float* w_in; const float* conv_w; const float* a_log; const float* dt_bias; const float* gnorm_w; const float* w_out; const float* final_norm_w;
    float* out; unsigned char* ws; int ph_lo, ph_hi;
};

namespace pg8 {
#define PG8_LAS __attribute__((address_space(3)))
constexpr int BM = 256, BK = 64, HALF = 128, HTB = HALF * BK * 2, STAGE_BYTES = 8 * HTB, NXCD = 8, WGM = 8;
__host__ __device__ __forceinline__ int lds_byte(int r, int c) { const int st = (r >> 4) * 2 + (c >> 5), rr = r & 15, cc = c & 31, ob = rr * 64 + cc * 2; return st * 1024 + (ob ^ (((ob >> 9) & 1) << 5)); }
__host__ __device__ __forceinline__ void stage_rc(int b, int& R, int& C) { const int st = b / 1024, sb = b % 1024, swz = sb ^ (((sb >> 9) & 1) << 5); R = (st >> 1) * 16 + swz / 64; C = (st & 1) * 32 + (swz % 64) / 2; }
__host__ __device__ __forceinline__ int perm32(int rho) { const int n = rho >> 4, i = rho & 15; return 8 * (i >> 2) + 4 * n + (i & 3); }
struct Unit { int pm, pn; };
struct Gemm { const bf16_t* A; const bf16_t* Bt; int M, N, K; };
struct StaticOrder {
    int nM, nN, nwg, G, c;
    __host__ __device__ void init(int M, int N, int G_, int c_) { nM = M / BM; nN = N / BM; nwg = nM * nN; G = G_; c = c_; }
    __host__ __device__ bool next(int i, Unit& u) const {
        const long L = (long)i * G + c; if (L >= nwg) return false;
        int wgid = (int)L; { const int q = nwg / NXCD, r = nwg % NXCD, xcd = wgid % NXCD, off = wgid / NXCD; wgid = (xcd < r ? xcd * (q + 1) : r * (q + 1) + (xcd - r) * q) + off; }
        const int nig = WGM * nN, gid = wgid / nig, fm = gid * WGM, gsz = (nM - fm) < WGM ? (nM - fm) : WGM;
        u.pm = fm + ((wgid % nig) % gsz); u.pn = (wgid % nig) / gsz; return true;
    }
    __device__ __forceinline__ void a_ready(const Unit&) const {}
    __device__ __forceinline__ void done(const Unit&) const {}
};

template <class Epi, class Sched>
__device__ __forceinline__ void gemm_phase(PG8_LAS unsigned char* lds, const Gemm g, const Sched& S, const Epi& E, int wv) {
    const int tid = opaque_tid(wv), wid = __builtin_amdgcn_readfirstlane(tid >> 6), lane = tid & 63, wr = wid >> 2, wc = wid & 3, fr = lane & 15, fq = lane >> 4;
    const int K = g.K, nt = K / BK;
    unsigned voffA[2], voffB[2];
#pragma unroll
    for (int i = 0; i < 2; ++i) { int R, C; stage_rc(tid * 16 + i * 8192, R, C); const int Rb = Epi::PERM ? ((R & ~31) + perm32(R & 31)) : R;
        voffA[i] = (unsigned)(R * K + C) * 2u; voffB[i] = (unsigned)(Rb * K + C) * 2u; }
    const size_t kstep = (size_t)(BK * 2);
    const size_t hstep = (size_t)HALF * K * 2;
    const size_t tstep = 2 * hstep;
    const unsigned ldsw = (unsigned)wid * 1024u;
    const int aoff = lds_byte(wr * 64 + fr, fq * 8), boff = lds_byte(wc * 32 + fr, fq * 8);
#define PG8_SA(b, h) (((b) * 2 + (h)) * HTB)
#define PG8_SB(b, h) ((4 + (b) * 2 + (h)) * HTB)
#define PG8_STAGE(bufoff, gbase, voff) do { _Pragma("unroll") for (int _i = 0; _i < 2; ++_i) \
        __builtin_amdgcn_global_load_lds((const unsigned*)((const char*)(gbase) + (voff)[_i]), (PG8_LAS unsigned*)(lds + (bufoff) + ldsw + _i * 8192), 16, 0, 0); } while (0)
#define PG8_LDA(dst, b, h) do { _Pragma("unroll") for (int m = 0; m < 4; ++m) _Pragma("unroll") for (int k = 0; k < 2; ++k) dst[m][k] = *(const PG8_LAS bf16x8*)(lds + PG8_SA(b, h) + aoff + m * 2048 + k * 1024); } while (0)
#define PG8_LDB(dst, b, h) do { _Pragma("unroll") for (int n = 0; n < 2; ++n) _Pragma("unroll") for (int k = 0; k < 2; ++k) dst[n][k] = *(const PG8_LAS bf16x8*)(lds + PG8_SB(b, h) + boff + n * 2048 + k * 1024); } while (0)
#define PG8_MMA(ai, bj, At, Bt) do { __builtin_amdgcn_s_setprio(1); _Pragma("unroll") for (int m = 0; m < 4; ++m) _Pragma("unroll") for (int n = 0; n < 2; ++n) _Pragma("unroll") for (int k = 0; k < 2; ++k) \
        acc[ai][bj][m][n] = __builtin_amdgcn_mfma_f32_16x16x32_bf16(Bt[n][k], At[m][k], acc[ai][bj][m][n], 0, 0, 0); __builtin_amdgcn_s_setprio(0); } while (0)
#define PG8_WAIT_V(n) asm volatile("s_waitcnt vmcnt(" #n ")" ::: "memory")
#define PG8_WAIT_L(n) asm volatile("s_waitcnt lgkmcnt(" #n ")" ::: "memory")
#define PG8_BAR __builtin_amdgcn_s_barrier()
#define PG8_SCHED __builtin_amdgcn_sched_barrier(0)
    Unit cur, nxt; int ui = 0;
    if (!S.next(0, cur)) return;
    f32x4 acc[2][2][4][2];
#pragma unroll
    for (int a = 0; a < 2; ++a)
#pragma unroll
        for (int b = 0; b < 2; ++b)
#pragma unroll
            for (int m = 0; m < 4; ++m)
#pragma unroll
                for (int n = 0; n < 2; ++n) acc[a][b][m][n] = (f32x4){0.f, 0.f, 0.f, 0.f};
    bf16x8 At[4][2], B0[2][2], B1[2][2];
    const char* cA = (const char*)g.A + (size_t)cur.pm * tstep; const char* cB = (const char*)g.Bt + (size_t)cur.pn * tstep;
    S.a_ready(cur);
    PG8_STAGE(PG8_SB(0, 0), cB, voffB); PG8_STAGE(PG8_SA(0, 0), cA, voffA); PG8_STAGE(PG8_SB(0, 1), cB + hstep, voffB); PG8_STAGE(PG8_SA(0, 1), cA + hstep, voffA);
    if (wr == 1) PG8_BAR;
    PG8_WAIT_V(4); PG8_BAR;
    PG8_STAGE(PG8_SB(1, 0), cB + kstep, voffB); PG8_STAGE(PG8_SA(1, 0), cA + kstep, voffA); PG8_STAGE(PG8_SB(1, 1), cB + hstep + kstep, voffB);
    PG8_WAIT_V(6); PG8_BAR;
    for (;;) {
        const bool has_next = S.next(ui + 1, nxt);
        const char* nA = has_next ? (const char*)g.A + (size_t)nxt.pm * tstep : cA; const char* nB = has_next ? (const char*)g.Bt + (size_t)nxt.pn * tstep : cB;
        for (int t = 0; t < nt; t += 2) {
            const bool last = (t == nt - 2);
            const char* a1 = cA + (size_t)(t + 1) * kstep;
            const char* a2 = last ? nA : cA + (size_t)(t + 2) * kstep; const char* b2 = last ? nB : cB + (size_t)(t + 2) * kstep;
            const char* a3 = a2 + kstep; const char* b3 = b2 + kstep;
            if (last && has_next) S.a_ready(nxt);
            PG8_LDB(B0, 0, 0); PG8_SCHED; PG8_LDA(At, 0, 0); PG8_STAGE(PG8_SA(1, 1), a1 + hstep, voffA);
            PG8_WAIT_L(8); PG8_BAR; PG8_WAIT_L(0); PG8_MMA(0, 0, At, B0); PG8_BAR; PG8_SCHED;
            PG8_LDB(B1, 0, 1); PG8_STAGE(PG8_SB(0, 0), b2, voffB);
            PG8_BAR; PG8_WAIT_L(0); PG8_MMA(0, 1, At, B1); PG8_BAR;
            PG8_LDA(At, 0, 1); PG8_STAGE(PG8_SA(0, 0), a2, voffA);
            PG8_BAR; PG8_WAIT_L(0); PG8_MMA(1, 0, At, B0); PG8_BAR; PG8_SCHED;
            PG8_STAGE(PG8_SB(0, 1), b2 + hstep, voffB);
            PG8_WAIT_V(6); PG8_BAR; PG8_MMA(1, 1, At, B1); PG8_BAR;
            PG8_LDB(B0, 1, 0); PG8_SCHED; PG8_LDA(At, 1, 0); PG8_STAGE(PG8_SA(0, 1), a2 + hstep, voffA);
            PG8_WAIT_L(8); PG8_BAR; PG8_WAIT_L(0); PG8_MMA(0, 0, At, B0); PG8_BAR; PG8_SCHED;
            PG8_LDB(B1, 1, 1); PG8_STAGE(PG8_SB(1, 0), b3, voffB);
            PG8_BAR; PG8_WAIT_L(0); PG8_MMA(0, 1, At, B1); PG8_BAR;
            PG8_LDA(At, 1, 1); PG8_STAGE(PG8_SA(1, 0), a3, voffA);
            PG8_BAR; PG8_WAIT_L(0); PG8_MMA(1, 0, At, B0); PG8_BAR; PG8_SCHED;
            PG8_STAGE(PG8_SB(1, 1), b3 + hstep, voffB);
            PG8_WAIT_V(6); PG8_BAR; PG8_MMA(1, 1, At, B1); PG8_BAR;
        }
        E(acc, cur, wr, wc, fr, fq); S.done(cur);
        if (!has_next) break;
#pragma unroll
        for (int a = 0; a < 2; ++a)
#pragma unroll
            for (int b = 0; b < 2; ++b)
#pragma unroll
                for (int m = 0; m < 4; ++m)
#pragma unroll
                    for (int n = 0; n < 2; ++n) acc[a][b][m][n] = (f32x4){0.f, 0.f, 0.f, 0.f};
        cur = nxt; cA = nA; cB = nB; ++ui;
    }
    PG8_WAIT_V(0);
    if (wr == 0) PG8_BAR;
    PG8_BAR;
#undef PG8_SA
#undef PG8_SB
#undef PG8_STAGE
#undef PG8_LDA
#undef PG8_LDB
#undef PG8_MMA
#undef PG8_WAIT_V
#undef PG8_WAIT_L
#undef PG8_BAR
#undef PG8_SCHED
}

struct EpiProj {
    static constexpr bool PERM = true, AFTER_DRAIN = false;
    bf16_t* proj; float* ab;
    __device__ __forceinline__ void operator()(const f32x4 (&acc)[2][2][4][2], const Unit& u, int wr, int wc, int fr, int fq) const {
        const int row0 = u.pm * BM + wr * 64 + fr;
        if (u.pn < 28) {
            const int col0 = u.pn * BM + wc * 32 + 8 * fq;
#pragma unroll
            for (int ai = 0; ai < 2; ++ai)
#pragma unroll
                for (int m = 0; m < 4; ++m) { bf16_t* rowp = proj + (size_t)(row0 + ai * HALF + m * 16) * NPROJ + col0;
#pragma unroll
                    for (int bj = 0; bj < 2; ++bj) { const f32x4 v0 = acc[ai][bj][m][0], v1 = acc[ai][bj][m][1];
                        u32x4 w; w.x = cvt_pk_bf16(v0[0], v0[1]); w.y = cvt_pk_bf16(v0[2], v0[3]); w.z = cvt_pk_bf16(v1[0], v1[1]); w.w = cvt_pk_bf16(v1[2], v1[3]);
                        *(u32x4*)(rowp + bj * HALF) = w; } }
        } else {
            const int c0 = wc * 32 + 8 * fq;
#pragma unroll
            for (int ai = 0; ai < 2; ++ai)
#pragma unroll
                for (int m = 0; m < 4; ++m) { float* rowp = ab + (size_t)(row0 + ai * HALF + m * 16) * NAB;
#pragma unroll
                    for (int n = 0; n < 2; ++n) { const int c = c0 + 4 * n; if (c < NAB) *(f32x4*)(rowp + c) = acc[ai][0][m][n]; } }
        }
    }
};
struct EpiRes {
    static constexpr bool PERM = false, AFTER_DRAIN = false;
    const float* xin_ctx; const float* xin_lat; float* xout; const float* gate;
    __device__ __forceinline__ void operator()(const f32x4 (&acc)[2][2][4][2], const Unit& u, int wr, int wc, int fr, int fq) const {
        const int row0 = u.pm * BM + wr * 64 + fr, col0 = u.pn * BM + wc * 32 + 4 * fq;
        const int mr = u.pm < 16 ? 0 : 1 + ((u.pm - 16) >> 3);
        const float* xin = u.pm < 16 ? xin_ctx : xin_lat;
        const float* g = gate + (size_t)mr * 6144 + col0;
        f32x4 gv[2][2];
#pragma unroll
        for (int bj = 0; bj < 2; ++bj)
#pragma unroll
            for (int n = 0; n < 2; ++n) gv[bj][n] = *(const f32x4*)(g + bj * HALF + n * 16);
#pragma unroll
        for (int ai = 0; ai < 2; ++ai)
#pragma unroll
            for (int m = 0; m < 4; ++m) { const size_t off = (size_t)(row0 + ai * HALF + m * 16) * D + col0;
#pragma unroll
                for (int bj = 0; bj < 2; ++bj)
#pragma unroll
                    for (int n = 0; n < 2; ++n) { const f32x4 xi = *(const f32x4*)(xin + off + bj * HALF + n * 16);
                        *(f32x4*)(xout + off + bj * HALF + n * 16) = xi + gv[bj][n] * acc[ai][bj][m][n]; } }
    }
};
}

__device__ void p0_prologue(const Args& a, unsigned char* lds, int bid, int nb, int wv) {
    const int tid = opaque_tid(wv);
    float* mod = (float*)(a.ws + WS_MOD);
    float* cs = (float*)lds;
    float* red = cs + 5 * 2048;
    for (int i = tid; i < 5 * 2048; i += NTHREADS) { const int r = i >> 11, k = i & 2047; const float cv = r == 0 ? a.c_ctx[k] : a.c[(r - 1) * 2048 + k]; cs[i] = silu_f(cv); }
    __syncthreads();
    const int c4 = tid & 15, kg = tid >> 4;
    for (int tile = bid; tile < 384; tile += nb) {
        const int l = tile / 96, n0 = (tile % 96) * 64;
        float acc[5][4];
#pragma unroll
        for (int r = 0; r < 5; ++r)
#pragma unroll
            for (int j = 0; j < 4; ++j) acc[r][j] = 0.f;
        const float* wp = a.w_mod + ((size_t)l * 2048 + kg * 64) * 6144 + n0 + c4 * 4;
#pragma unroll 4
        for (int kk = 0; kk < 64; ++kk) {
            const f32x4 w = *(const f32x4*)(wp + (size_t)kk * 6144);
#pragma unroll
            for (int r = 0; r < 5; ++r) { const float s = cs[r * 2048 + kg * 64 + kk];
#pragma unroll
                for (int j = 0; j < 4; ++j) acc[r][j] += s * w[j]; }
        }
#pragma unroll
        for (int r = 0; r < 5; ++r)
#pragma unroll
            for (int j = 0; j < 4; ++j) red[(kg * 5 + r) * 64 + c4 * 4 + j] = acc[r][j];
        __syncthreads();
        if (tid < 320) { const int r = tid >> 6, c = tid & 63; float s = 0.f;
            for (int g = 0; g < 32; ++g) s += red[(g * 5 + r) * 64 + c];
            mod[(size_t)(l * 5 + r) * 6144 + n0 + c] = s + a.b_mod[(size_t)l * 6144 + n0 + c]; }
        __syncthreads();
    }
}

__device__ void ph_wconv(const Args& a, int l, unsigned char* lds, int tb, int te, int bid, int nb, int wv) {
    const int tid = opaque_tid(wv);
    float* tl = (float*)lds;
    bf16_t* WinT = (bf16_t*)(a.ws + WS_WINT) + (size_t)(l & 1) * NPAD * D; bf16_t* WoutT = (bf16_t*)(a.ws + WS_WOUTT);
    for (int t = tb + bid; t < te; t += nb) {
        const float* src; bf16_t* dst; int ldn, nt, kt;
        if (t < 1856) { nt = t >> 4; kt = t & 15; src = a.w_in + (size_t)l * D * DIN; ldn = DIN; dst = WinT; }
        else { const int r = t - 1856; nt = r >> 4; kt = r & 15; src = a.w_out + (size_t)l * D * D; ldn = D; dst = WoutT; }
        const int n0 = nt * 64, k0 = kt * 128;
        for (int i = tid; i < 2048; i += NTHREADS) { const int kr = i >> 4, cc = (i & 15) * 4, n = n0 + cc;
            f32x4 v = (f32x4){0.f, 0.f, 0.f, 0.f};
            if (n < ldn) v = *(const f32x4*)(src + (size_t)(k0 + kr) * ldn + n);
            float* p = tl + kr * 65 + cc; p[0] = v[0]; p[1] = v[1]; p[2] = v[2]; p[3] = v[3]; }
        __syncthreads();
        for (int i = tid; i < 1024; i += NTHREADS) { const int kc = i & 15, n = i >> 4; const float* p = tl + (kc * 8) * 65 + n;
            u32x4 w; w.x = cvt_pk_bf16(p[0], p[65]); w.y = cvt_pk_bf16(p[130], p[195]); w.z = cvt_pk_bf16(p[260], p[325]); w.w = cvt_pk_bf16(p[390], p[455]);
            *(u32x4*)(dst + (size_t)(n0 + n) * D + k0 + kc * 8) = w; }
        __syncthreads();
    }
}

__device__ void ph_norm_mod(const float* xc, const float* xl, const float* nw, const float* modl, bf16_t* h, int bid, int nb, int wv) {
    const int tid = opaque_tid(wv), lane = tid & 63, wid = tid >> 6;
    for (int m = bid * 8 + wid; m < MTOK; m += nb * 8) {
        const float* xr = (m < NCTX ? xc : xl) + (size_t)m * D;
        const int mr = m < NCTX ? 0 : 1 + ((m - NCTX) >> 11);
        const float* sh = modl + (size_t)mr * 6144; const float* sc = sh + 2048;
        f32x4 v[8], w8[8], s8[8], h8[8]; float ss = 0.f;
#pragma unroll
        for (int j = 0; j < 8; ++j) { const int k = j * 256 + lane * 4; v[j] = *(const f32x4*)(xr + k); w8[j] = *(const f32x4*)(nw + k); s8[j] = *(const f32x4*)(sc + k); h8[j] = *(const f32x4*)(sh + k); }
        __builtin_amdgcn_sched_barrier(0);
#pragma unroll
        for (int j = 0; j < 8; ++j) ss += v[j][0] * v[j][0] + v[j][1] * v[j][1] + v[j][2] * v[j][2] + v[j][3] * v[j][3];
        ss = wave_sum(ss, lane);
        const float rstd = rsqrtf(ss * (1.0f / D) + EPS);
#pragma unroll
        for (int j = 0; j < 8; ++j) { const int k = j * 256 + lane * 4;
            const f32x4 w4 = w8[j], s4 = s8[j], h4 = h8[j];
            f32x4 y;
#pragma unroll
            for (int i = 0; i < 4; ++i) y[i] = v[j][i] * rstd * w4[i] * (1.0f + s4[i]) + h4[i];
            u32x2 w; w.x = cvt_pk_bf16(y[0], y[1]); w.y = cvt_pk_bf16(y[2], y[3]);
            *(u32x2*)(h + (size_t)m * D + k) = w; }
    }
}

__device__ void ph_final_norm(const float* x, const float* nw, float* out, int bid, int nb, int wv) {
    const int tid = opaque_tid(wv), lane = tid & 63, wid = tid >> 6;
    for (int m = bid * 8 + wid; m < MTOK; m += nb * 8) {
        const float* xr = x + (size_t)m * D;
        f32x4 v[8]; float ss = 0.f;
#pragma unroll
        for (int j = 0; j < 8; ++j) { v[j] = *(const f32x4*)(xr + j * 256 + lane * 4); ss += v[j][0] * v[j][0] + v[j][1] * v[j][1] + v[j][2] * v[j][2] + v[j][3] * v[j][3]; }
        ss = wave_sum(ss, lane);
        const float rstd = rsqrtf(ss * (1.0f / D) + EPS);
#pragma unroll
        for (int j = 0; j < 8; ++j) { const int k = j * 256 + lane * 4; const f32x4 w4 = *(const f32x4*)(nw + k);
            *(f32x4*)(out + (size_t)m * D + k) = v[j] * rstd * w4; }
    }
}

constexpr int L_KT = 0, L_QT = 17408, L_KTT = 34816, L_VTT = 53248, L_LF = 71680, L_LB = 89088, L_ATTS = 106496, L_WS1 = 124928, L_VEC = 142336;
constexpr int V_GF = 0, V_GB = 64, V_BF = 128, V_BB = 192, V_EGF = 256, V_EGB = 320, V_EDF = 384, V_EDB = 448, V_BGF = 512, V_BGB = 576;
static_assert(L_VEC + 640 * 4 <= LDS_BYTES, "LDS map");

__device__ __forceinline__ void build_frags(const unsigned char* src, int stride, int nKt, int nFr, const float* rowsc, const float* colsc, u32x4* dst, int t0, int nthr, bool swz = false) {
    for (int p = t0; p < nFr * 64; p += nthr) {
        const int lane = p & 63, f = p >> 6, s = f & 1, kt = (f >> 1) % nKt, mt = (f >> 1) / nKt, r = lane & 31, h = lane >> 5;
        const int row = 32 * mt + r, k0 = 32 * kt + 16 * s + 4 * h;
        const int sx = swz ? ((row >> 4) & 7) : 0;
        u32x2 lo = *(const u32x2*)(src + row * stride + (((k0 >> 3) ^ sx) << 4) + (k0 & 7) * 2), hi = *(const u32x2*)(src + row * stride + ((((k0 >> 3) + 1) ^ sx) << 4) + (k0 & 7) * 2);
        if (rowsc || colsc) {
            float v[8] = {bf_lo(lo.x), bf_hi(lo.x), bf_lo(lo.y), bf_hi(lo.y), bf_lo(hi.x), bf_hi(hi.x), bf_lo(hi.y), bf_hi(hi.y)};
            if (rowsc) { const float rs = rowsc[row];
#pragma unroll
                for (int i = 0; i < 8; ++i) v[i] *= rs; }
            if (colsc) { const f32x4 c0 = *(const f32x4*)(colsc + k0), c1 = *(const f32x4*)(colsc + k0 + 8);
#pragma unroll
                for (int i = 0; i < 4; ++i) { v[i] *= c0[i]; v[4 + i] *= c1[i]; } }
            lo.x = cvt_pk_bf16(v[0], v[1]); lo.y = cvt_pk_bf16(v[2], v[3]); hi.x = cvt_pk_bf16(v[4], v[5]); hi.y = cvt_pk_bf16(v[6], v[7]);
        }
        u32x4 w; w.x = lo.x; w.y = lo.y; w.z = hi.x; w.w = hi.y;
        __builtin_nontemporal_store(w, dst + p);
    }
}

template <int C, int S> __device__ __forceinline__ void tri_fma(const f32x4 (&cur)[16], float (&t)[64], float& a0, float& a1, float& a2, float& a3) {
    if constexpr (S < C) {
        const f32x4 l4 = cur[S / 4];
        a0 -= l4[0] * t[S];
        if constexpr (S + 1 < C) a1 -= l4[1] * t[S + 1];
        if constexpr (S + 2 < C) a2 -= l4[2] * t[S + 2];
        if constexpr (S + 3 < C) a3 -= l4[3] * t[S + 3];
        tri_fma<C, S + 4>(cur, t, a0, a1, a2, a3);
    }
}
template <int C, int S> __device__ __forceinline__ void tri_load(const float* Lr, f32x4 (&dst)[16]) {
    if constexpr (S < C) { dst[S / 4] = *(const f32x4*)(Lr + S); tri_load<C, S + 4>(Lr, dst); }
}
template <int C> __device__ __forceinline__ void tri_rows(const float* L, int j, float (&t)[64], const f32x4 (&cur)[16]) {
    if constexpr (C < 64) {
        f32x4 nxt[16];
        if constexpr (C + 1 < 64) tri_load<C + 1, 0>(L + (C + 1) * 68, nxt);
        __builtin_amdgcn_sched_barrier(0);
        float a0 = (C == j) ? 1.f : 0.f, a1 = 0.f, a2 = 0.f, a3 = 0.f;
        tri_fma<C, 0>(cur, t, a0, a1, a2, a3);
        t[C] = (a0 + a1) + (a2 + a3);
        tri_rows<C + 1>(L, j, t, nxt);
    }
}
__device__ __forceinline__ void tri_inverse(const float* L, int j, float (&t)[64]) { f32x4 r0[16]; tri_rows<0>(L, j, t, r0); }

__device__ __forceinline__ bf16x8 as_bf16x8(u32x4 w) { union { u32x4 u; bf16x8 b; } c; c.u = w; return c.b; }
__device__ __forceinline__ bf16x8 pack8(const f32x16& v, int o) {
    u32x4 w; w.x = cvt_pk_bf16(v[o], v[o + 1]); w.y = cvt_pk_bf16(v[o + 2], v[o + 3]); w.z = cvt_pk_bf16(v[o + 4], v[o + 5]); w.w = cvt_pk_bf16(v[o + 6], v[o + 7]); return as_bf16x8(w);
}
#define MFMA32(a, b, c) __builtin_amdgcn_mfma_f32_32x32x16_bf16((a), (b), (c), 0, 0, 0)

__device__ void ph_f12(const Args& a, int bid, int nb, int wv);
__device__ void ph_pre(const Args& a, int l, unsigned char* lds, int bid, int nb, int wv) {
    const bf16_t* proj = (const bf16_t*)(a.ws + WS_PROJ); const float* ab = (const float*)(a.ws + WS_AB);
    const float* cw = a.conv_w + (size_t)l * 3 * 4608;
    float* vec = (float*)(lds + L_VEC);
    float* EG = (float*)(a.ws + WS_EG);
    u32x4 xr[3][3][2]; f32x4 wr0[3][4];
#define PRE_ISSUE_X(itn, tidx) do { const int gcn = (itn) / NH, hdn = (itn) - gcn * NH; const int cn = (tidx) >> 3, ch0n = ((tidx) & 7) * 16, mn = gcn * 64 + cn; \
        int tn, lenn; if (mn < NCTX) { tn = mn & 255; lenn = 256; } else { tn = (mn - NCTX) & 2047; lenn = 2048; } const bool hpn = tn > 0, hnn = tn < lenn - 1; \
        _Pragma("unroll") for (int part = 0; part < 3; ++part) { const bf16_t* pn = proj + (size_t)mn * NPROJ + 1024 + part * DD + hdn * HD + ch0n; const u32x4 zz = (u32x4){0u, 0u, 0u, 0u}; \
            xr[part][1][0] = *(const u32x4*)pn; xr[part][1][1] = *(const u32x4*)(pn + 8); \
            if (hpn) { xr[part][0][0] = *(const u32x4*)(pn - NPROJ); xr[part][0][1] = *(const u32x4*)(pn - NPROJ + 8); } else { xr[part][0][0] = zz; xr[part][0][1] = zz; } \
            if (hnn) { xr[part][2][0] = *(const u32x4*)(pn + NPROJ); xr[part][2][1] = *(const u32x4*)(pn + NPROJ + 8); } else { xr[part][2][0] = zz; xr[part][2][1] = zz; } } \
        _Pragma("unroll") for (int tp = 0; tp < 3; ++tp) _Pragma("unroll") for (int q4 = 0; q4 < 4; ++q4) wr0[tp][q4] = *(const f32x4*)(cw + tp * 4608 + hdn * HD + ch0n + q4 * 4); } while (0)
    const int vb = (nb & 7) == 0 ? (bid & 7) * (nb >> 3) + (bid >> 3) : bid;
    { const int tid0 = opaque_tid(wv); PRE_ISSUE_X(vb, tid0); }
#pragma unroll 1
    for (int it = vb; it < 192 * NH; it += nb) {
        const int tid = opaque_tid(wv), lane = tid & 63, wid = tid >> 6, r = lane & 31, h = lane >> 5;
        const int gc = it / NH, hd = it - gc * NH;
        const int m0 = gc * 64;
        {
            const int c = tid >> 3, ch0 = (tid & 7) * 16;
            float y[3][16];
#pragma unroll
            for (int part = 0; part < 3; ++part) {
                const int col = part * DD + hd * HD + ch0;
                u32x4 x1[2], x0[2], x2[2];
                x0[0] = xr[part][0][0]; x0[1] = xr[part][0][1]; x1[0] = xr[part][1][0]; x1[1] = xr[part][1][1]; x2[0] = xr[part][2][0]; x2[1] = xr[part][2][1];
#pragma unroll
                for (int q4 = 0; q4 < 4; ++q4) {
                    const f32x4 w0 = part == 0 ? wr0[0][q4] : *(const f32x4*)(cw + col + q4 * 4), w1 = part == 0 ? wr0[1][q4] : *(const f32x4*)(cw + 4608 + col + q4 * 4), w2 = part == 0 ? wr0[2][q4] : *(const f32x4*)(cw + 2 * 4608 + col + q4 * 4);
                    const unsigned a0 = x0[q4 >> 1][(q4 & 1) * 2], a1 = x0[q4 >> 1][(q4 & 1) * 2 + 1];
                    const unsigned b0 = x1[q4 >> 1][(q4 & 1) * 2], b1 = x1[q4 >> 1][(q4 & 1) * 2 + 1];
                    const unsigned c0 = x2[q4 >> 1][(q4 & 1) * 2], c1 = x2[q4 >> 1][(q4 & 1) * 2 + 1];
                    y[part][q4 * 4 + 0] = silu_f(w0[0] * bf_lo(a0) + w1[0] * bf_lo(b0) + w2[0] * bf_lo(c0));
                    y[part][q4 * 4 + 1] = silu_f(w0[1] * bf_hi(a0) + w1[1] * bf_hi(b0) + w2[1] * bf_hi(c0));
                    y[part][q4 * 4 + 2] = silu_f(w0[2] * bf_lo(a1) + w1[2] * bf_lo(b1) + w2[2] * bf_lo(c1));
                    y[part][q4 * 4 + 3] = silu_f(w0[3] * bf_hi(a1) + w1[3] * bf_hi(b1) + w2[3] * bf_hi(c1));
                }
            }
            float sq = 0.f, sk = 0.f;
#pragma unroll
            for (int i = 0; i < 16; ++i) { sq += y[0][i] * y[0][i]; sk += y[1][i] * y[1][i]; }
            sq += lshfl(sq, lane ^ 1); sq += lshfl(sq, lane ^ 2); sq += lshfl(sq, lane ^ 4);
            sk += lshfl(sk, lane ^ 1); sk += lshfl(sk, lane ^ 2); sk += lshfl(sk, lane ^ 4);
            const float rq = rsqrtf(sq + EPS) * 0.08838834764831845f, rk = rsqrtf(sk + EPS);
            u32x4 wq[2], wk[2];
#pragma unroll
            for (int i = 0; i < 8; ++i) { wq[i >> 2][i & 3] = cvt_pk_bf16(y[0][2 * i] * rq, y[0][2 * i + 1] * rq); wk[i >> 2][i & 3] = cvt_pk_bf16(y[1][2 * i] * rk, y[1][2 * i + 1] * rk); }
            *(u32x4*)(lds + L_QT + c * 272 + ch0 * 2) = wq[0]; *(u32x4*)(lds + L_QT + c * 272 + ch0 * 2 + 16) = wq[1];
            *(u32x4*)(lds + L_KT + c * 272 + ch0 * 2) = wk[0]; *(u32x4*)(lds + L_KT + c * 272 + ch0 * 2 + 16) = wk[1];
#pragma unroll
            for (int i = 0; i < 8; ++i) {
                const int tsw = ((((c >> 3) ^ (tid & 7)) & 7) << 4) + (c & 7) * 2;
                const unsigned kk = wk[i >> 2][i & 3];
                *(bf16_t*)(lds + L_KTT + (ch0 + 2 * i) * 144 + tsw) = (bf16_t)(kk & 0xffffu);
                *(bf16_t*)(lds + L_KTT + (ch0 + 2 * i + 1) * 144 + tsw) = (bf16_t)(kk >> 16);
                const unsigned vv = cvt_pk_bf16(y[2][2 * i], y[2][2 * i + 1]);
                *(bf16_t*)(lds + L_VTT + (ch0 + 2 * i) * 144 + tsw) = (bf16_t)(vv & 0xffffu);
                *(bf16_t*)(lds + L_VTT + (ch0 + 2 * i + 1) * 144 + tsw) = (bf16_t)(vv >> 16);
            }
        }
        if (wid == 0) {
            const float* abr = ab + (size_t)(m0 + lane) * NAB;
            const float xf = abr[hd] + a.dt_bias[(l * 2 + 0) * NH + hd], xb = abr[NH + hd] + a.dt_bias[(l * 2 + 1) * NH + hd];
            const float lgf = -expf(a.a_log[(l * 2 + 0) * NH + hd]) * (fmaxf(xf, 0.f) + log1pf(expf(-fabsf(xf))));
            const float lgb = -expf(a.a_log[(l * 2 + 1) * NH + hd]) * (fmaxf(xb, 0.f) + log1pf(expf(-fabsf(xb))));
            const float bfw = 1.0f / (1.0f + expf(-abr[2 * NH + hd])), bbw = 1.0f / (1.0f + expf(-abr[3 * NH + hd]));
            float gf = lgf, gb = lgb;
#pragma unroll
            for (int o = 1; o < 64; o <<= 1) { const float uf = lshfl(gf, lane >= o ? lane - o : lane), ub = lshfl(gb, lane + o < 64 ? lane + o : lane); if (lane >= o) gf += uf; if (lane + o < 64) gb += ub; }
            const float glf = lshfl(gf, 63), glb = lshfl(gb, 0);
            const float egf = expf(gf), egb = expf(gb);
            vec[V_GF + lane] = gf; vec[V_GB + lane] = gb; vec[V_BF + lane] = bfw; vec[V_BB + lane] = bbw;
            vec[V_EGF + lane] = egf; vec[V_EGB + lane] = egb; vec[V_EDF + lane] = expf(glf - gf); vec[V_EDB + lane] = expf(glb - gb);
            vec[V_BGF + lane] = bfw * egf; vec[V_BGB + lane] = bbw * egb;
            if (lane < 2) EG[(size_t)(gc * NH + hd) * 2 + lane] = expf(lane == 0 ? glf : glb);
        }
        __syncthreads();
        {
            const int mat = wid >> 2, tile = wid & 3, mt = tile >> 1, nt = tile & 1;
            const unsigned char* As = lds + (mat == 0 ? L_KT : L_QT) + (32 * mt + r) * 272 + h * 16;
            const unsigned char* Bs = lds + L_KT + (32 * nt + r) * 272 + h * 16;
            f32x16 acc;
#pragma unroll
            for (int i = 0; i < 16; ++i) acc[i] = 0.f;
#pragma unroll
            for (int kh = 0; kh < 2; ++kh) { bf16x8 fa[4], fb[4];
#pragma unroll
                for (int k4 = 0; k4 < 4; ++k4) { fa[k4] = *(const bf16x8*)(As + (kh * 4 + k4) * 32); fb[k4] = *(const bf16x8*)(Bs + (kh * 4 + k4) * 32); }
#pragma unroll
                for (int k4 = 0; k4 < 4; ++k4) acc = MFMA32(fa[k4], fb[k4], acc); }
            const int s = 32 * nt + r;
            const float gfs = vec[V_GF + s], gbs = vec[V_GB + s];
            f32x4 gfc[4], gbc[4], bfc[4], bbc[4];
#pragma unroll
            for (int q = 0; q < 4; ++q) { const int c0 = 32 * mt + 8 * q + 4 * h;
                gfc[q] = *(const f32x4*)(vec + V_GF + c0); gbc[q] = *(const f32x4*)(vec + V_GB + c0); bfc[q] = *(const f32x4*)(vec + V_BF + c0); bbc[q] = *(const f32x4*)(vec + V_BB + c0); }
#pragma unroll
            for (int i = 0; i < 16; ++i) {
                const int c = 32 * mt + (i & 3) + 8 * (i >> 2) + 4 * h;
                const float df = __expf(fminf(gfc[i >> 2][i & 3] - gfs, 0.f)), db = __expf(fminf(gbc[i >> 2][i & 3] - gbs, 0.f));
                if (mat == 0) {
                    *(float*)(lds + L_LF + (c * 68 + s) * 4) = (c > s) ? bfc[i >> 2][i & 3] * acc[i] * df : 0.f;
                    *(float*)(lds + L_LB + ((63 - c) * 68 + (63 - s)) * 4) = (c < s) ? bbc[i >> 2][i & 3] * acc[i] * db : 0.f;
                } else {
                    *(bf16_t*)(lds + L_ATTS + c * 144 + s * 2) = (bf16_t)(cvt_pk_bf16((c >= s) ? acc[i] * df : 0.f, 0.f) & 0xffffu);
                    *(bf16_t*)(lds + L_ATTS + 9216 + c * 144 + s * 2) = (bf16_t)(cvt_pk_bf16((c <= s) ? acc[i] * db : 0.f, 0.f) & 0xffffu);
                }
            }
        }
        __syncthreads();
        unsigned char* sb0 = a.ws + WS_SCAN + (size_t)((gc * NH + hd) * 2) * SCAN_STRIDE;
        if (wid < 2) {
            float t[64];
            float* L = (float*)(lds + (wid == 0 ? L_LF : L_LB));
            tri_inverse(L, lane, t);
            float* Lw = wid == 0 ? L + lane : L + 63 * 68 + (63 - lane);
            const int rstep = wid == 0 ? 68 : -68;
#pragma unroll
            for (int c = 0; c < 64; ++c) Lw[c * rstep] = t[c];
            { const int itn = it + nb < 192 * NH ? it + nb : it; PRE_ISSUE_X(itn, tid); }
        } else {
            { const int itn = it + nb < 192 * NH ? it + nb : it; PRE_ISSUE_X(itn, tid); }
            const int t0 = tid - 128, nthr = NTHREADS - 128;
#pragma unroll 1
            for (int d = 0; d < 2; ++d) {
                unsigned char* sb = sb0 + (size_t)d * SCAN_STRIDE;
                build_frags(lds + L_QT, 272, 4, 16, vec + (d ? V_EGB : V_EGF), nullptr, (u32x4*)(sb + 16384), t0, nthr);
                build_frags(lds + L_KTT, 144, 2, 16, nullptr, vec + (d ? V_EDB : V_EDF), (u32x4*)(sb + 32768), t0, nthr, true);
                build_frags(lds + L_ATTS + d * 9216, 144, 2, 8, nullptr, nullptr, (u32x4*)(sb + 49152), t0, nthr);
            }
        }
        __syncthreads();
        {
            const int d = wid >> 2, nt = wid & 3;
            const float* T = (const float*)(lds + (d ? L_LB : L_LF));
            const float* bsc = vec + (d ? V_BB : V_BF); const float* gsc = vec + (d ? V_BGB : V_BGF);
            f32x16 aU[2], aW[2];
#pragma unroll
            for (int mt = 0; mt < 2; ++mt)
#pragma unroll
                for (int i = 0; i < 16; ++i) { aU[mt][i] = 0.f; aW[mt][i] = 0.f; }
#pragma unroll
            for (int ks = 0; ks < 4; ++ks) {
                const int k0 = 16 * ks + 8 * h;
                const int gsw = (((k0 >> 3) ^ ((32 * nt + r) >> 4)) & 7) << 4;
                const bf16x8 bv = *(const bf16x8*)(lds + L_VTT + (32 * nt + r) * 144 + gsw), bk = *(const bf16x8*)(lds + L_KTT + (32 * nt + r) * 144 + gsw);
                const f32x4 b0 = *(const f32x4*)(bsc + k0), b1 = *(const f32x4*)(bsc + k0 + 4), g0 = *(const f32x4*)(gsc + k0), g1 = *(const f32x4*)(gsc + k0 + 4);
#pragma unroll
                for (int mt = 0; mt < 2; ++mt) {
                    const float* Tr = T + (32 * mt + r) * 68 + k0;
                    const f32x4 t0 = *(const f32x4*)Tr, t1 = *(const f32x4*)(Tr + 4);
                    u32x4 wb, wg;
                    wb.x = cvt_pk_bf16(t0[0] * b0[0], t0[1] * b0[1]); wb.y = cvt_pk_bf16(t0[2] * b0[2], t0[3] * b0[3]); wb.z = cvt_pk_bf16(t1[0] * b1[0], t1[1] * b1[1]); wb.w = cvt_pk_bf16(t1[2] * b1[2], t1[3] * b1[3]);
                    wg.x = cvt_pk_bf16(-t0[0] * g0[0], -t0[1] * g0[1]); wg.y = cvt_pk_bf16(-t0[2] * g0[2], -t0[3] * g0[3]); wg.z = cvt_pk_bf16(-t1[0] * g1[0], -t1[1] * g1[1]); wg.w = cvt_pk_bf16(-t1[2] * g1[2], -t1[3] * g1[3]);
                    aU[mt] = MFMA32(as_bf16x8(wb), bv, aU[mt]);
                    aW[mt] = MFMA32(as_bf16x8(wg), bk, aW[mt]);
                }
            }
            unsigned char* sb = sb0 + (size_t)d * SCAN_STRIDE;
            unsigned char* stg = lds + (d ? L_WS1 : L_QT);
#pragma unroll
            for (int mt = 0; mt < 2; ++mt) {
#pragma unroll
                for (int hf = 0; hf < 2; ++hf) { u32x4 w;
                    w.x = cvt_pk_bf16(aU[mt][8 * hf + 0], aU[mt][8 * hf + 1]); w.y = cvt_pk_bf16(aU[mt][8 * hf + 2], aU[mt][8 * hf + 3]);
                    w.z = cvt_pk_bf16(aU[mt][8 * hf + 4], aU[mt][8 * hf + 5]); w.w = cvt_pk_bf16(aU[mt][8 * hf + 6], aU[mt][8 * hf + 7]);
                    __builtin_nontemporal_store(w, (u32x4*)(sb + 57344 + (size_t)((((mt * 4 + nt) * 2 + hf) * 64 + lane) * 16))); }
#pragma unroll
                for (int i = 0; i < 16; ++i) { const int c = 32 * mt + (i & 3) + 8 * (i >> 2) + 4 * h;
                    *(bf16_t*)(stg + c * 272 + (32 * nt + r) * 2) = (bf16_t)(cvt_pk_bf16(aW[mt][i], 0.f) & 0xffffu); }
            }
        }
        __syncthreads();
#pragma unroll 1
        for (int d = 0; d < 2; ++d) build_frags(lds + (d ? L_WS1 : L_QT), 272, 4, 16, nullptr, nullptr, (u32x4*)(sb0 + (size_t)d * SCAN_STRIDE), tid, NTHREADS);
        __syncthreads();
    }
    ph_f12(a, bid, nb, wv);
}

constexpr int FT1 = 0, FT2L = 4096, FT2C = 4096 + 2048, FT3 = 4096 + 2048 + 16384, FT_ENTRIES = 4096 + 2048 + 16384 + 256;
__device__ void ph_ftables(const Args& a, int bid, int nb, int wv) {
    const int tid = opaque_tid(wv);
    u32x4* tab = (u32x4*)(a.ws + WS_FT);
    for (int e = bid * NTHREADS + tid; e < FT_ENTRIES; e += nb * NTHREADS) {
        float v[8];
        if (e < FT2L) { const int lane = e & 63, ks = (e >> 6) & 7, cs = (e >> 9) & 1, nt = e >> 10, np = 32 * nt + (lane & 31), h = lane >> 5;
#pragma unroll
            for (int j = 0; j < 8; ++j) { const int k = 16 * ks + 8 * h + j, x = (k * np) & 127; v[j] = cs ? sinpif((float)x * (2.0f / 128.0f)) : cospif((float)x * (2.0f / 128.0f)); } }
        else if (e < FT2C) { const int e2 = e - FT2L, lane = e2 & 63, f = e2 >> 6, s = f & 1, kt = (f >> 1) & 3, mt = f >> 3, row = 32 * mt + (lane & 31), h = lane >> 5;
#pragma unroll
            for (int j = 0; j < 8; ++j) { const int k = 32 * kt + 16 * s + 8 * (j >> 2) + 4 * h + (j & 3), ri = row >> 6, wp = row & 63, pq = k >> 6, w = k & 63, x = (w * wp) & 63;
                const float c = cospif((float)x * (2.0f / 64.0f)), sn = sinpif((float)x * (2.0f / 64.0f));
                v[j] = ri == 0 ? (pq == 0 ? c : -sn) : (pq == 0 ? -sn : -c); } }
        else if (e < FT3) { const int e3 = e - FT2C, lane = e3 & 63, f = e3 >> 6, s = f & 1, kt = (f >> 1) & 15, mt = f >> 5, wp = 32 * mt + (lane & 31), h = lane >> 5;
#pragma unroll
            for (int j = 0; j < 8; ++j) { const int k = 32 * kt + 16 * s + 8 * (j >> 2) + 4 * h + (j & 3), pq = k >> 8, w = k & 255, x = (w * wp) & 255;
                v[j] = pq == 0 ? cospif((float)x * (2.0f / 256.0f)) : -sinpif((float)x * (2.0f / 256.0f)); } }
        else { const int e4 = e - FT3, lane = e4 & 63, ks = e4 >> 6, rp = lane & 31, h = lane >> 5;
#pragma unroll
            for (int j = 0; j < 8; ++j) { const int k = 16 * ks + 8 * h + j, ri = k >> 5, rr = k & 31, x = (rr * rp) & 31; v[j] = ri ? sinpif((float)x * (2.0f / 32.0f)) : cospif((float)x * (2.0f / 32.0f)); } }
        u32x4 w; w.x = cvt_pk_bf16(v[0], v[1]); w.y = cvt_pk_bf16(v[2], v[3]); w.z = cvt_pk_bf16(v[4], v[5]); w.w = cvt_pk_bf16(v[6], v[7]);
        tab[e] = w;
    }
}

__device__ __forceinline__ void f_stage1_s(const bf16_t* proj, const u32x4* tab, int m0, int g, int nt, int lane, f32x16 (&P)[2], f32x16 (&Q)[2]) {
    const int r = lane & 31, h = lane >> 5;
#pragma unroll
    for (int mt = 0; mt < 2; ++mt)
#pragma unroll
        for (int i = 0; i < 16; ++i) { P[mt][i] = 0.f; Q[mt][i] = 0.f; }
#pragma unroll
    for (int ks = 0; ks < 8; ++ks) {
        const bf16x8 bc = as_bf16x8(tab[FT1 + ((nt * 2 + 0) * 8 + ks) * 64 + lane]), bs = as_bf16x8(tab[FT1 + ((nt * 2 + 1) * 8 + ks) * 64 + lane]);
#pragma unroll
        for (int mt = 0; mt < 2; ++mt) {
            const bf16x8 av = *(const bf16x8*)(proj + (size_t)(m0 + 32 * mt + r) * NPROJ + g * 128 + 16 * ks + 8 * h);
            P[mt] = MFMA32(av, bc, P[mt]); Q[mt] = MFMA32(av, bs, Q[mt]);
        }
    }
}

__device__ __forceinline__ void f_stage1(const bf16_t* proj, const u32x4* tab, int m0, int g, int nt, int lane, f32x16 (&P)[2], f32x16 (&Q)[2]) {
    const int r = lane & 31, h = lane >> 5;
#pragma unroll
    for (int mt = 0; mt < 2; ++mt)
#pragma unroll
        for (int i = 0; i < 16; ++i) { P[mt][i] = 0.f; Q[mt][i] = 0.f; }
#pragma unroll
    for (int kb = 0; kb < 4; ++kb) {
        bf16x8 bc[2], bs[2], av[2][2];
#pragma unroll
        for (int k4 = 0; k4 < 2; ++k4) { const int ks = kb * 2 + k4;
            bc[k4] = as_bf16x8(tab[FT1 + ((nt * 2 + 0) * 8 + ks) * 64 + lane]); bs[k4] = as_bf16x8(tab[FT1 + ((nt * 2 + 1) * 8 + ks) * 64 + lane]);
#pragma unroll
            for (int mt = 0; mt < 2; ++mt) av[k4][mt] = *(const bf16x8*)(proj + (size_t)(m0 + 32 * mt + r) * NPROJ + g * 128 + 16 * ks + 8 * h); }
        __builtin_amdgcn_sched_barrier(0);
#pragma unroll
        for (int k4 = 0; k4 < 2; ++k4)
#pragma unroll
            for (int mt = 0; mt < 2; ++mt) { P[mt] = MFMA32(av[k4][mt], bc[k4], P[mt]); Q[mt] = MFMA32(av[k4][mt], bs[k4], Q[mt]); }
        __builtin_amdgcn_sched_barrier(0);
    }
}

__device__ void ph_f12(const Args& a, int bid, int nb, int wv) {
    const int tid = opaque_tid(wv), lane = tid & 63, wid = tid >> 6, r = lane & 31, h = lane >> 5;
    const bf16_t* proj = (const bf16_t*)(a.ws + WS_PROJ);
    const u32x4* tab = (const u32x4*)(a.ws + WS_FT);
    bf16_t* yf = (bf16_t*)(a.ws + WS_YF);
    bf16_t* Z = (bf16_t*)(a.ws + WS_Z);
    if (bid < 128) {
        const int b = bid >> 3, g = (bid >> 1) & 3, nt = wid & 3, mq = (bid & 1) * 2 + (wid >> 2);
        f32x16 ZR[2];
#pragma unroll
        for (int q = 0; q < 2; ++q)
#pragma unroll
            for (int i = 0; i < 16; ++i) ZR[q][i] = 0.f;
#pragma unroll 1
        for (int j = 0; j < 4; ++j) {
            f32x16 P[2], Q[2];
            f_stage1(proj, tab, b * 256 + j * 64, g, nt, lane, P, Q);
            bf16x8 Pb[2][2], Qb[2][2];
#pragma unroll
            for (int t = 0; t < 2; ++t) { Pb[t][0] = pack8(P[t], 0); Pb[t][1] = pack8(P[t], 8); Qb[t][0] = pack8(Q[t], 0); Qb[t][1] = pack8(Q[t], 8); }
#pragma unroll
            for (int q = 0; q < 2; ++q) { const int mt = 2 * mq + q;
                bf16x8 fp[4], fq[4];
#pragma unroll
                for (int ts = 0; ts < 4; ++ts) { fp[ts] = as_bf16x8(tab[FT2C + ((mt * 16 + 2 * j) * 2 + ts) * 64 + lane]); fq[ts] = as_bf16x8(tab[FT2C + ((mt * 16 + 8 + 2 * j) * 2 + ts) * 64 + lane]); }
                __builtin_amdgcn_sched_barrier(0);
#pragma unroll
                for (int ts = 0; ts < 4; ++ts) { ZR[q] = MFMA32(fp[ts], Pb[ts >> 1][ts & 1], ZR[q]); ZR[q] = MFMA32(fq[ts], Qb[ts >> 1][ts & 1], ZR[q]); }
                __builtin_amdgcn_sched_barrier(0);
            }
        }
        const float sc = 0.005524271728019903f;
#pragma unroll
        for (int q = 0; q < 2; ++q)
#pragma unroll
            for (int i = 0; i < 16; ++i) { const int wp = 32 * (2 * mq + q) + (i & 3) + 8 * (i >> 2) + 4 * h; const size_t m = (size_t)b * 256 + wp; const int col = g * 128 + 32 * nt + r;
                const float z = bf1(proj[m * NPROJ + 512 + col]);
                yf[m * DF + col] = (bf16_t)(cvt_pk_bf16(ZR[q][i] * sc * silu_f(z), 0.f) & 0xffffu); }
    } else {
#pragma unroll 1
        for (int item = (bid - 128) * 2 + (wid >> 2); item < 512; item += (nb - 128) * 2) {
            const int R = item >> 2, g = item & 3, nt = wid & 3, b = R >> 5, rr = R & 31;
            f32x16 P[2], Q[2];
            f_stage1_s(proj, tab, NCTX + R * 64, g, nt, lane, P, Q);
            bf16x8 Pb[2][2], Qb[2][2];
#pragma unroll
            for (int t = 0; t < 2; ++t) { Pb[t][0] = pack8(P[t], 0); Pb[t][1] = pack8(P[t], 8); Qb[t][0] = pack8(Q[t], 0); Qb[t][1] = pack8(Q[t], 8); }
#pragma unroll
            for (int mt = 0; mt < 4; ++mt) {
                f32x16 acc;
#pragma unroll
                for (int i = 0; i < 16; ++i) acc[i] = 0.f;
#pragma unroll
                for (int q8 = 0; q8 < 8; ++q8) acc = MFMA32(as_bf16x8(tab[FT2L + (mt * 8 + q8) * 64 + lane]), q8 < 4 ? Pb[q8 >> 1][q8 & 1] : Qb[(q8 >> 1) - 2][q8 & 1], acc);
                const int ri = mt >> 1;
#pragma unroll
                for (int i = 0; i < 16; ++i) { const int wp = 32 * (mt & 1) + (i & 3) + 8 * (i >> 2) + 4 * h;
                    Z[(((size_t)(b * 4 + g) * 64 + ri * 32 + rr) * 64 + wp) * 128 + 32 * nt + r] = (bf16_t)(cvt_pk_bf16(acc[i], 0.f) & 0xffffu); }
            }
        }
    }
}

__device__ __forceinline__ void f3_tile(const Args& a, int t, int lane) {
    const int r = lane & 31, h = lane >> 5;
    const bf16_t* proj = (const bf16_t*)(a.ws + WS_PROJ);
    const u32x4* tab = (const u32x4*)(a.ws + WS_FT);
    bf16_t* yf = (bf16_t*)(a.ws + WS_YF);
    const bf16_t* Z = (const bf16_t*)(a.ws + WS_Z);
    const int bg = t >> 6, b = bg >> 2, g = bg & 3, wp = t & 63;
    const float sc = 0.001953125f;
#pragma unroll 1
    for (int cb = 0; cb < 4; ++cb) {
        const int c0 = cb * 32;
        const bf16_t* zp = Z + (((size_t)bg * 64 + 8 * h) * 64 + wp) * 128 + c0 + r;
        f32x16 acc;
#pragma unroll
        for (int i = 0; i < 16; ++i) acc[i] = 0.f;
#pragma unroll
        for (int ks = 0; ks < 4; ++ks) {
            u32x4 w;
#pragma unroll
            for (int q = 0; q < 4; ++q) { const unsigned lo = zp[(size_t)(16 * ks + 2 * q) * 8192], hi = zp[(size_t)(16 * ks + 2 * q + 1) * 8192]; w[q] = lo | (hi << 16); }
            acc = MFMA32(as_bf16x8(tab[FT3 + ks * 64 + lane]), as_bf16x8(w), acc);
        }
#pragma unroll
        for (int i = 0; i < 16; ++i) { const int rp = (i & 3) + 8 * (i >> 2) + 4 * h; const size_t m = (size_t)NCTX + b * 2048 + rp * 64 + wp; const int col = g * 128 + c0 + r;
            const float z = bf1(proj[m * NPROJ + 512 + col]);
            yf[m * DF + col] = (bf16_t)(cvt_pk_bf16(acc[i] * sc * silu_f(z), 0.f) & 0xffffu); }
    }
}

__device__ void ph_rec(const Args& a, int l, unsigned char* lds_, int bid, int nb, int wv) {
    const int tid = opaque_tid(wv), lane = tid & 63, wid = __builtin_amdgcn_readfirstlane(tid >> 6), r = lane & 31, h = lane >> 5;
    PG8_LAS unsigned char* lds = (PG8_LAS unsigned char*)lds_;
    bf16_t* ob = (bf16_t*)(a.ws + WS_O);
    const float* EG = (const float*)(a.ws + WS_EG);
    float* state_new = a.out + (size_t)MTOK * D;
    const bool lat = bid < 96;
    const bool act = wid < 4;
    const int dvq = wid & 3;
#define REC_DMA(bp, buf) do { _Pragma("unroll") for (int q = 0; q < 14; ++q) __builtin_amdgcn_global_load_lds((const unsigned*)((bp) + (dvq * 14 + q) * 1024 + lane * 16), (PG8_LAS unsigned*)(lds + (buf) * 57344 + (dvq * 14 + q) * 1024), 16, 0, 0); } while (0)
#define REC_SYNC() do { asm volatile("s_waitcnt vmcnt(0) lgkmcnt(0)" ::: "memory"); __builtin_amdgcn_s_barrier(); asm volatile("" ::: "memory"); } while (0)
#define LFRAG(off) (*(const PG8_LAS bf16x8*)(gl + (off) + lane * 16))
#pragma unroll 1
    for (int cidx = lat ? bid : bid - 96; cidx < (lat ? 96 : 384); cidx += (lat ? 96 : nb - 96)) {
        const int b = cidx / 24, rem = cidx - b * 24, hd = rem >> 1, dir = rem & 1;
        const int gc0 = lat ? 64 + b * 32 : b * 4, nch = lat ? 32 : 4;
        const size_t soff = ((((size_t)b * DEPTH + l) * 2 + dir) * NH + hd) * (size_t)(HD * HD) + dvq * 32 + r;
        f32x16 S[4];
#pragma unroll
        for (int dt = 0; dt < 4; ++dt)
#pragma unroll
            for (int i = 0; i < 16; ++i) S[dt][i] = (lat && act) ? a.state_ctx[soff + (size_t)(32 * dt + (i & 3) + 8 * (i >> 2) + 4 * h) * HD] : 0.f;
        const int stepdir = dir ? -1 : 1;
        int gc = gc0 + (dir ? nch - 1 : 0);
        const unsigned char* base = a.ws + WS_SCAN + (size_t)((gc * NH + hd) * 2 + dir) * SCAN_STRIDE;
        const long bstep = (long)stepdir * (long)(NH * 2) * (long)SCAN_STRIDE;
        u32x4 un[2][2];
        float egl = 0.f;
        if (act) {
            REC_DMA(base, 0);
#pragma unroll
            for (int mt = 0; mt < 2; ++mt)
#pragma unroll
                for (int hf = 0; hf < 2; ++hf) un[mt][hf] = *((const u32x4*)(base + 57344) + ((mt * 4 + dvq) * 2 + hf) * 64 + lane);
            egl = EG[(gc * NH + hd) * 2 + dir];
        }
        REC_SYNC();
#pragma unroll 1
        for (int st = 0; st < nch; ++st) {
            const bool more = st + 1 < nch;
            const unsigned char* nbase = base + bstep;
            if (act) {
                PG8_LAS unsigned char* gl = lds + (st & 1) * 57344;
                f32x16 av[2], ao[2];
#pragma unroll
                for (int mt = 0; mt < 2; ++mt)
#pragma unroll
                    for (int hf = 0; hf < 2; ++hf) { const u32x4 u = un[mt][hf];
                        av[mt][8 * hf + 0] = bf_lo(u.x); av[mt][8 * hf + 1] = bf_hi(u.x); av[mt][8 * hf + 2] = bf_lo(u.y); av[mt][8 * hf + 3] = bf_hi(u.y);
                        av[mt][8 * hf + 4] = bf_lo(u.z); av[mt][8 * hf + 5] = bf_hi(u.z); av[mt][8 * hf + 6] = bf_lo(u.w); av[mt][8 * hf + 7] = bf_hi(u.w); }
                const float egc = egl;
                if (more) { REC_DMA(nbase, (st + 1) & 1);
#pragma unroll
                    for (int mt = 0; mt < 2; ++mt)
#pragma unroll
                        for (int hf = 0; hf < 2; ++hf) un[mt][hf] = *((const u32x4*)(nbase + 57344) + ((mt * 4 + dvq) * 2 + hf) * 64 + lane);
                    egl = EG[((gc + stepdir) * NH + hd) * 2 + dir]; }
                bf16x8 Sb[4][2];
#pragma unroll
                for (int dt = 0; dt < 4; ++dt) { Sb[dt][0] = pack8(S[dt], 0); Sb[dt][1] = pack8(S[dt], 8); }
#pragma unroll
                for (int mt = 0; mt < 2; ++mt) {
                    bf16x8 fr[8];
#pragma unroll
                    for (int q = 0; q < 8; ++q) fr[q] = LFRAG((mt * 8 + q) * 1024);
                    __builtin_amdgcn_sched_barrier(0);
#pragma unroll
                    for (int q = 0; q < 8; ++q) av[mt] = MFMA32(fr[q], Sb[q >> 1][q & 1], av[mt]);
                    __builtin_amdgcn_sched_barrier(0);
                }
#pragma unroll
                for (int mt = 0; mt < 2; ++mt) {
#pragma unroll
                    for (int i = 0; i < 16; ++i) ao[mt][i] = 0.f;
                    bf16x8 fr[8];
#pragma unroll
                    for (int q = 0; q < 8; ++q) fr[q] = LFRAG(16384 + (mt * 8 + q) * 1024);
                    __builtin_amdgcn_sched_barrier(0);
#pragma unroll
                    for (int q = 0; q < 8; ++q) ao[mt] = MFMA32(fr[q], Sb[q >> 1][q & 1], ao[mt]);
                    __builtin_amdgcn_sched_barrier(0);
                }
                bf16x8 Vb[2][2];
#pragma unroll
                for (int tt = 0; tt < 2; ++tt) { Vb[tt][0] = pack8(av[tt], 0); Vb[tt][1] = pack8(av[tt], 8); }
                {
                    bf16x8 fr[8];
#pragma unroll
                    for (int q = 0; q < 8; ++q) fr[q] = LFRAG(32768 + 16384 + q * 1024);
#pragma unroll
                    for (int q = 0; q < 8; ++q) ao[q >> 2] = MFMA32(fr[q], Vb[(q >> 1) & 1][q & 1], ao[q >> 2]);
                }
#pragma unroll
                for (int dh = 0; dh < 2; ++dh) {
                    bf16x8 fr[8];
#pragma unroll
                    for (int q = 0; q < 8; ++q) fr[q] = LFRAG(32768 + (dh * 8 + q) * 1024);
#pragma unroll
                    for (int i = 0; i < 16; ++i) { S[2 * dh][i] *= egc; S[2 * dh + 1][i] *= egc; }
#pragma unroll
                    for (int q = 0; q < 8; ++q) S[2 * dh + (q >> 2)] = MFMA32(fr[q], Vb[(q >> 1) & 1][q & 1], S[2 * dh + (q >> 2)]);
                }
                bf16_t* op = ob + ((size_t)dir * MTOK + (size_t)gc * 64) * DD + hd * HD + dvq * 32 + r;
#pragma unroll
                for (int mt = 0; mt < 2; ++mt)
#pragma unroll
                    for (int i = 0; i < 16; ++i) op[(size_t)(32 * mt + (i & 3) + 8 * (i >> 2) + 4 * h) * DD] = (bf16_t)(cvt_pk_bf16(ao[mt][i], 0.f) & 0xffffu);
            }
            REC_SYNC();
            base = nbase; gc += stepdir;
        }
        if (!lat && act) {
#pragma unroll
            for (int dt = 0; dt < 4; ++dt)
#pragma unroll
                for (int i = 0; i < 16; ++i) state_new[soff + (size_t)(32 * dt + (i & 3) + 8 * (i >> 2) + 4 * h) * HD] = S[dt][i];
        }
    }
#undef REC_DMA
#undef REC_SYNC
#undef LFRAG
    if (bid >= 96) {
        const int nl = (bid - 96) * 8 + wid, nnl = (nb - 96) * 8;
#pragma unroll 1
        for (int t = nl; t < 1024; t += nnl) f3_tile(a, t, lane);
    }
}

__device__ void ph_d(const Args& a, int l, unsigned char* lds, int bid, int nb, int wv) {
    const int tid = opaque_tid(wv), lane = tid & 63, wid = tid >> 6;
    const bf16_t* proj = (const bf16_t*)(a.ws + WS_PROJ);
    bf16_t* ycat = (bf16_t*)(a.ws + WS_H);
    const bf16_t* ob = (const bf16_t*)(a.ws + WS_O);
    const bf16_t* yf = (const bf16_t*)(a.ws + WS_YF);
    const float* gnw = a.gnorm_w + l * HD + (lane & 15) * 8;
#pragma unroll 1
    for (int it = bid * 8 + wid; it < MTOK * 3; it += nb * 8) {
        const int m = it / 3, j = it - m * 3;
        const size_t o = (size_t)m * DD + j * 512 + lane * 8;
        const u32x4 fa = *(const u32x4*)(ob + o), fb = *(const u32x4*)(ob + (size_t)MTOK * DD + o), zz = *(const u32x4*)(proj + (size_t)m * NPROJ + 5632 + j * 512 + lane * 8);
        if (j == 0) *(u32x4*)(ycat + (size_t)m * D + lane * 8) = *(const u32x4*)(yf + (size_t)m * DF + lane * 8);
        const f32x4 g0 = *(const f32x4*)gnw, g1 = *(const f32x4*)(gnw + 4);
        const float gw8[8] = {g0[0], g0[1], g0[2], g0[3], g1[0], g1[1], g1[2], g1[3]};
        float v[8], z[8]; float ss = 0.f;
#pragma unroll
        for (int q = 0; q < 4; ++q) { v[2 * q] = bf_lo(fa[q]) + bf_lo(fb[q]); v[2 * q + 1] = bf_hi(fa[q]) + bf_hi(fb[q]); z[2 * q] = bf_lo(zz[q]); z[2 * q + 1] = bf_hi(zz[q]); }
#pragma unroll
        for (int q = 0; q < 8; ++q) ss += v[q] * v[q];
        ss += lshfl(ss, lane ^ 1); ss += lshfl(ss, lane ^ 2); ss += lshfl(ss, lane ^ 4); ss += lshfl(ss, lane ^ 8);
        const float rstd = rsqrtf(ss * (1.0f / HD) + EPS);
        u32x4 w;
#pragma unroll
        for (int q = 0; q < 4; ++q) w[q] = cvt_pk_bf16(v[2 * q] * rstd * gw8[2 * q] * silu_f(z[2 * q]), v[2 * q + 1] * rstd * gw8[2 * q + 1] * silu_f(z[2 * q + 1]));
        *(u32x4*)(ycat + (size_t)m * D + DF + j * 512 + lane * 8) = w;
    }
}

#define XB_TMO      128
#define XB_XCNT(j)  (256  + 64 * (j))
#define XB_XSUB(j)  (1280 + 64 * (j))
#define XB_XGEN(j)  (2304 + 64 * (j))
#define XB_TOP      3328
#define XB_TOPGEN   3392
#define XCD_BAR_WORDS 3456
#define XB_SPIN_CAP (1u << 20)
__device__ __forceinline__ unsigned xb_ld(unsigned* p)              { return __hip_atomic_load(p, __ATOMIC_RELAXED, __HIP_MEMORY_SCOPE_AGENT); }
__device__ __forceinline__ unsigned xb_add(unsigned* p, unsigned v) { return __hip_atomic_fetch_add(p, v, __ATOMIC_RELAXED, __HIP_MEMORY_SCOPE_AGENT); }
__device__ __forceinline__ unsigned xb_xcc_id() { return (unsigned)__builtin_amdgcn_s_getreg((3 << 11) | 20) & 0xFu; }
#define XB_SPIN(cond, bar) do { unsigned _sp = 0; while (cond) { __builtin_amdgcn_s_sleep(1); \
    if ((++_sp & 255u) == 0u) { if (xb_ld(&(bar)[XB_TMO])) break; if (_sp > XB_SPIN_CAP) { atomicAdd(&(bar)[XB_TMO], 1u); break; } } } } while (0)
struct XcdBarrier { unsigned* bar; unsigned x; volatile PG8_LAS unsigned* st; };
__device__ __forceinline__ XcdBarrier xcd_barrier_post(unsigned* bar, volatile PG8_LAS unsigned* st) {
    XcdBarrier b; b.bar = bar; b.x = xb_xcc_id(); b.st = st;
    if (threadIdx.x == 0) (void)xb_add(&bar[XB_XCNT(b.x)], 1u);
    return b;
}
__device__ __forceinline__ void xcd_barrier_complete(unsigned* bar, unsigned x, unsigned& nloc, unsigned& nx) {
    const unsigned G = gridDim.x * gridDim.y * gridDim.z;
    unsigned sum, cnt, mine, sp = 0u;
    for (;;) {
        sum = 0u; cnt = 0u; mine = 0u;
#pragma unroll
        for (unsigned j = 0; j < 16; ++j) { const unsigned c = xb_ld(&bar[XB_XCNT(j)]); sum += c; cnt += (c > 0u) ? 1u : 0u; mine = (j == x) ? c : mine; }
        if (sum == G) break;
        __builtin_amdgcn_s_sleep(1);
        if ((++sp & 255u) == 0u) { if (xb_ld(&bar[XB_TMO])) break; if (sp > XB_SPIN_CAP) { atomicAdd(&bar[XB_TMO], 1u); break; } }
    }
    nloc = mine > 0u ? mine : 1u; nx = cnt > 0u ? cnt : 1u;
}
__device__ __forceinline__ void xcd_barrier(const XcdBarrier& b) {
    asm volatile("s_waitcnt vmcnt(0)" ::: "memory");
    __syncthreads();
    if (threadIdx.x == 0) {
        unsigned* bar = b.bar;
        __builtin_amdgcn_s_waitcnt(0);
        unsigned nloc = b.st[0], nx = b.st[1];
        if (nloc == 0u) { xcd_barrier_complete(bar, b.x, nloc, nx); b.st[0] = nloc; b.st[1] = nx; }
        const unsigned old = xb_add(&bar[XB_XSUB(b.x)], 1u);
        const unsigned gen = old / nloc;
        if (old + 1u == (gen + 1u) * nloc) {
            __builtin_amdgcn_fence(__ATOMIC_RELEASE, "agent");
            asm volatile("s_waitcnt vmcnt(0)" ::: "memory");
            const unsigned og = xb_add(&bar[XB_TOP], 1u);
            const unsigned tg = og / nx;
            if (og + 1u == (tg + 1u) * nx) xb_add(&bar[XB_TOPGEN], 1u);
            else XB_SPIN(xb_ld(&bar[XB_TOPGEN]) == tg, bar);
            __builtin_amdgcn_fence(__ATOMIC_ACQUIRE, "agent");
            xb_add(&bar[XB_XGEN(b.x)], 1u);
            asm volatile("s_waitcnt vmcnt(0)" ::: "memory");
        } else {
            XB_SPIN(xb_ld(&bar[XB_XGEN(b.x)]) == gen, bar);
            __builtin_amdgcn_fence(__ATOMIC_ACQUIRE, "agent");
            asm volatile("s_waitcnt vmcnt(0)" ::: "memory");
        }
    }
    __syncthreads();
}

constexpr int NPH = 1 + DEPTH * 6 + 1;
constexpr int WCONV_EARLY = 1152;
__global__ void __launch_bounds__(NTHREADS, 2) mk_fwd(Args a) {
    const int ph_lo = a.ph_lo, ph_hi = a.ph_hi;
    const int wv = __builtin_amdgcn_readfirstlane((int)(threadIdx.x >> 6));
    unsigned char* const ws0 = a.ws;
    extern __shared__ __attribute__((aligned(16))) unsigned char shm[];
    cg::grid_group grid = cg::this_grid();
    const int bid = blockIdx.x, nb = gridDim.x;
    volatile PG8_LAS unsigned* bst = (volatile PG8_LAS unsigned*)((PG8_LAS unsigned char*)shm + LDS_BYTES - 16);
    XcdBarrier xb; xb.bar = (unsigned*)(ws0 + WS_BAR); xb.x = 0; xb.st = bst;
    if (ph_hi - ph_lo > 1) {
        if (threadIdx.x == 0) { bst[0] = 0u; bst[1] = 0u; }
        __syncthreads();
        xb = xcd_barrier_post((unsigned*)(ws0 + WS_BAR), bst);
    }
    for (int ph = ph_lo; ph < ph_hi; ++ph) {
        float* xws = (float*)(a.ws + WS_X);
        bf16_t* hb = (bf16_t*)(a.ws + WS_H);
        const float* mod = (const float*)(a.ws + WS_MOD);
        if (ph == 0) { p0_prologue(a, shm, bid, nb, wv); ph_ftables(a, bid, nb, wv); }
        else if (ph == NPH - 1) ph_final_norm(xws, a.final_norm_w, a.out, bid, nb, wv);
        else {
            const int l = (ph - 1) / 6, sub = (ph - 1) % 6;
            const float* xc = l == 0 ? a.x_prompt : xws; const float* xl = l == 0 ? a.x_sample - (size_t)NCTX * D : xws;
            const float* modl = mod + (size_t)l * 5 * 6144;
            if (sub == 0) { ph_norm_mod(xc, xl, a.norm_w + (size_t)l * D, modl, hb, bid, nb, wv); if (nb != 256) ph_wconv(a, l, shm, 0, 1856 + 512, bid, nb, wv); else if (l == 0) ph_wconv(a, 0, shm, 0, 1856, bid, nb, wv); }
            else if (sub == 1) {
                pg8::Gemm g{hb, (const bf16_t*)(a.ws + WS_WINT) + (size_t)(l & 1) * NPAD * D, MTOK, NPAD, D}; pg8::StaticOrder S; S.init(MTOK, NPAD, nb, bid);
                pg8::EpiProj E{(bf16_t*)(a.ws + WS_PROJ), (float*)(a.ws + WS_AB)};
                pg8::gemm_phase<pg8::EpiProj, pg8::StaticOrder>((PG8_LAS unsigned char*)shm, g, S, E, wv);
                if (nb == 256 && bid >= 112) { __syncthreads(); ph_wconv(a, l, shm, 1856, 1856 + 512, bid - 112, 144, wv); if (l + 1 < DEPTH) ph_wconv(a, l + 1, shm, WCONV_EARLY, 1856, bid - 112, 144, wv); }
            }
            else if (sub == 2) ph_pre(a, l, shm, bid, nb, wv);
            else if (sub == 3) ph_rec(a, l, shm, bid, nb, wv);
            else if (sub == 4) ph_d(a, l, shm, bid, nb, wv);
            else {
                pg8::Gemm g{hb, (const bf16_t*)(a.ws + WS_WOUTT), MTOK, D, D}; pg8::StaticOrder S; S.init(MTOK, D, nb, bid);
                pg8::EpiRes E{xc, xl, xws, modl + 4096};
                pg8::gemm_phase<pg8::EpiRes, pg8::StaticOrder>((PG8_LAS unsigned char*)shm, g, S, E, wv);
                if (l + 1 < DEPTH && nb == 256 && bid >= 128) { __syncthreads(); ph_wconv(a, l + 1, shm, 0, WCONV_EARLY, bid - 128, 128, wv); }
            }
        }
        if (ph + 1 < ph_hi) { if (ph == 0) grid.sync(); else xcd_barrier(xb); }
    }
}

extern "C" void kernel_launch(void* const* d_in, const int* in_sizes, int n_in, void* d_out, int out_size, void* d_ws, size_t ws_size, hipStream_t stream) {
    static int grid = 0;
    if (grid == 0) {
        if (ws_size < WS_END) { fprintf(stderr, "kernel_launch: workspace too small: %zu < %zu\n", ws_size, (size_t)WS_END); grid = -1; return; }
        int dev = 0, cus = 0;
        (void)hipGetDevice(&dev); (void)hipDeviceGetAttribute(&cus, hipDeviceAttributeMultiprocessorCount, dev);
        if (hipFuncSetAttribute((const void*)mk_fwd, hipFuncAttributeMaxDynamicSharedMemorySize, LDS_BYTES) != hipSuccess) { fprintf(stderr, "kernel_launch: hipFuncSetAttribute failed\n"); grid = -1; return; }
        int per_cu = 0;
        if (hipOccupancyMaxActiveBlocksPerMultiprocessor(&per_cu, (const void*)mk_fwd, NTHREADS, LDS_BYTES) != hipSuccess || per_cu < 1) { fprintf(stderr, "kernel_launch: occupancy query says %d\n", per_cu); }
        (void)hipGetLastError();
        grid = cus > 0 ? cus : 256;
    }
    if (grid < 0) return;
    Args a{};
    a.x_prompt = (const float*)d_in[0]; a.x_sample = (const float*)d_in[1]; a.state_ctx = (const float*)d_in[2]; a.c = (const float*)d_in[3]; a.c_ctx = (const float*)d_in[4];
    a.norm_w = (const float*)d_in[5]; a.w_mod = (const float*)d_in[6]; a.b_mod = (const float*)d_in[7]; a.w_in = (const float*)d_in[8]; a.conv_w = (const float*)d_in[9];
    a.a_log = (const float*)d_in[10]; a.dt_bias = (const float*)d_in[11]; a.gnorm_w = (const float*)d_in[12]; a.w_out = (const float*)d_in[13]; a.final_norm_w = (const float*)d_in[14];
    a.out = (float*)d_out; a.ws = (unsigned char*)d_ws;
#if ONE_LAUNCH
    (void)hipMemsetAsync((char*)d_ws + WS_BAR, 0, 16384, stream);
    a.ph_lo = 0; a.ph_hi = NPH;
    void* args[] = {&a};
    hipError_t e = hipLaunchCooperativeKernel((const void*)mk_fwd, dim3(grid), dim3(NTHREADS), args, LDS_BYTES, stream);
    if (e != hipSuccess) fprintf(stderr, "cooperative launch failed: %s (grid %d)\n", hipGetErrorString(e), grid);
#else
    for (int ph = 0; ph < NPH; ++ph) { a.ph_lo = ph; a.ph_hi = ph + 1; hipLaunchKernelGGL(mk_fwd, dim3(grid), dim3(NTHREADS), LDS_BYTES, stream, a); }
#endif
}
```

```cpp
#include <hip/hip_runtime.h>
#include <hip/hip_cooperative_groups.h>
#include <cstdio>
namespace cg = cooperative_groups;

#ifndef PROBE_DUP
#define PROBE_DUP -1
#endif
#ifndef ONE_LAUNCH
#define ONE_LAUNCH 1
#endif

constexpr int D = 2048, NCTX = 4096, NLAT = 8192, MTOK = 12288, DIN = 7216, NPAD = 7424, NPROJ = 7168;
constexpr int DEPTH = 4, NH = 12, HD = 128, DD = 1536, DF = 512, NAB = 48;
constexpr int NTHREADS = 512, LDS_BYTES = 147456;
constexpr float EPS = 1e-6f;

typedef unsigned short bf16_t;
typedef short bf16x8 __attribute__((ext_vector_type(8)));
typedef float f32x4 __attribute__((ext_vector_type(4)));
typedef float f32x16 __attribute__((ext_vector_type(16)));
typedef float f32x2 __attribute__((ext_vector_type(2)));
typedef unsigned u32x4 __attribute__((ext_vector_type(4)));
typedef unsigned u32x2 __attribute__((ext_vector_type(2)));

typedef __bf16 bf16v2 __attribute__((ext_vector_type(2)));
__device__ __forceinline__ unsigned cvt_pk_bf16(float lo, float hi) { f32x2 v = {lo, hi}; bf16v2 b = __builtin_convertvector(v, bf16v2); return __builtin_bit_cast(unsigned, b); }
__device__ __forceinline__ float bf_lo(unsigned w) { return __uint_as_float(w << 16); }
__device__ __forceinline__ float bf_hi(unsigned w) { return __uint_as_float(w & 0xffff0000u); }
__device__ __forceinline__ float bf1(bf16_t b) { return __uint_as_float(((unsigned)b) << 16); }
__device__ __forceinline__ float silu_f(float x) { return x * __builtin_amdgcn_rcpf(1.0f + __expf(-x)); }
__device__ __forceinline__ float lshfl(float v, int src) { return __builtin_bit_cast(float, __builtin_amdgcn_ds_bpermute(src << 2, __builtin_bit_cast(int, v))); }
__device__ __forceinline__ float wave_sum(float v, int lane) {
#pragma unroll
    for (int o = 32; o >= 1; o >>= 1) v += lshfl(v, lane ^ o);
    return v;
}

__device__ __forceinline__ int opaque_tid(int wv) { int l; asm volatile("v_mbcnt_lo_u32_b32 %0, -1, 0\n\tv_mbcnt_hi_u32_b32 %0, -1, %0" : "=v"(l)); return wv * 64 + l; }
constexpr size_t WS_WINT = 0;
constexpr size_t WS_WOUTT = WS_WINT + (size_t)2 * NPAD * D * 2;
constexpr size_t WS_MOD = WS_WOUTT + (size_t)D * D * 2;
constexpr size_t WS_X = WS_MOD + (size_t)DEPTH * 5 * 6144 * 4;
constexpr size_t WS_H = WS_X + (size_t)MTOK * D * 4;
constexpr size_t WS_PROJ = WS_H + (size_t)MTOK * D * 2;
constexpr size_t WS_AB = WS_PROJ + (size_t)MTOK * NPROJ * 2;
constexpr size_t WS_O = WS_AB + (size_t)MTOK * NAB * 4;
constexpr size_t WS_Z = WS_O + (size_t)2 * MTOK * DD * 2;
constexpr size_t WS_FT = WS_Z + (size_t)16 * 64 * 128 * 64 * 2;
constexpr int NCI = 192 * NH * 2;
constexpr size_t SCAN_STRIDE = 73728;
constexpr size_t WS_SCAN = WS_FT + (size_t)22784 * 16;
constexpr size_t WS_EG = WS_SCAN + (size_t)NCI * SCAN_STRIDE;
constexpr size_t WS_YF = WS_EG + (size_t)NCI * 4;
constexpr size_t WS_BAR = WS_YF + (size_t)MTOK * DF * 2;
constexpr size_t WS_END = WS_BAR + 16384;

struct Args {
    const float* x_prompt; const float* x_sample; const float* state_ctx; const float* c; const float* c_ctx; const float* norm_w; const float* w_mod; const float* b_mod;
    const float* w_in; const float* conv_w; const float* a_log; const float* dt_bias; const float* gnorm_w; const float* w_out; const float* final_norm_w;
    float* out; unsigned char* ws; int ph_lo, ph_hi;
};

namespace pg8 {
#define PG8_LAS __attribute__((address_space(3)))
constexpr int BM = 256, BK = 64, HALF = 128, HTB = HALF * BK * 2, STAGE_BYTES = 8 * HTB, NXCD = 8, WGM = 8;
__host__ __device__ __forceinline__ int lds_byte(int r, int c) { const int st = (r >> 4) * 2 + (c >> 5), rr = r & 15, cc = c & 31, ob = rr * 64 + cc * 2; return st * 1024 + (ob ^ (((ob >> 9) & 1) << 5)); }
__host__ __device__ __forceinline__ void stage_rc(int b, int& R, int& C) { const int st = b / 1024, sb = b % 1024, swz = sb ^ (((sb >> 9) & 1) << 5); R = (st >> 1) * 16 + swz / 64; C = (st & 1) * 32 + (swz % 64) / 2; }
__host__ __device__ __forceinline__ int perm32(int rho) { const int n = rho >> 4, i = rho & 15; return 8 * (i >> 2) + 4 * n + (i & 3); }
struct Unit { int pm, pn; };
struct Gemm { const bf16_t* A; const bf16_t* Bt; int M, N, K; };
struct StaticOrder {
    int nM, nN, nwg, G, c;
    __host__ __device__ void init(int M, int N, int G_, int c_) { nM = M / BM; nN = N / BM; nwg = nM * nN; G = G_; c = c_; }
    __host__ __device__ bool next(int i, Unit& u) const {
        const long L = (long)i * G + c; if (L >= nwg) return false;
        int wgid = (int)L; { const int q = nwg / NXCD, r = nwg % NXCD, xcd = wgid % NXCD, off = wgid / NXCD; wgid = (xcd < r ? xcd * (q + 1) : r * (q + 1) + (xcd - r) * q) + off; }
        const int nig = WGM * nN, gid = wgid / nig, fm = gid * WGM, gsz = (nM - fm) < WGM ? (nM - fm) : WGM;
        u.pm = fm + ((wgid % nig) % gsz); u.pn = (wgid % nig) / gsz; return true;
    }
    __device__ __forceinline__ void a_ready(const Unit&) const {}
    __device__ __forceinline__ void done(const Unit&) const {}
};

template <class Epi, class Sched>
__device__ __forceinline__ void gemm_phase(PG8_LAS unsigned char* lds, const Gemm g, const Sched& S, const Epi& E, int wv) {
    const int tid = opaque_tid(wv), wid = __builtin_amdgcn_readfirstlane(tid >> 6), lane = tid & 63, wr = wid >> 2, wc = wid & 3, fr = lane & 15, fq = lane >> 4;
    const int K = g.K, nt = K / BK;
    unsigned voffA[2], voffB[2];
#pragma unroll
    for (int i = 0; i < 2; ++i) { int R, C; stage_rc(tid * 16 + i * 8192, R, C); const int Rb = Epi::PERM ? ((R & ~31) + perm32(R & 31)) : R;
        voffA[i] = (unsigned)(R * K + C) * 2u; voffB[i] = (unsigned)(Rb * K + C) * 2u; }
    const size_t kstep = (size_t)(BK * 2);
    const size_t hstep = (size_t)HALF * K * 2;
    const size_t tstep = 2 * hstep;
    const unsigned ldsw = (unsigned)wid * 1024u;
    const int aoff = lds_byte(wr * 64 + fr, fq * 8), boff = lds_byte(wc * 32 + fr, fq * 8);
#define PG8_SA(b, h) (((b) * 2 + (h)) * HTB)
#define PG8_SB(b, h) ((4 + (b) * 2 + (h)) * HTB)
#define PG8_STAGE(bufoff, gbase, voff) do { _Pragma("unroll") for (int _i = 0; _i < 2; ++_i) \
        __builtin_amdgcn_global_load_lds((const unsigned*)((const char*)(gbase) + (voff)[_i]), (PG8_LAS unsigned*)(lds + (bufoff) + ldsw + _i * 8192), 16, 0, 0); } while (0)
#define PG8_LDA(dst, b, h) do { _Pragma("unroll") for (int m = 0; m < 4; ++m) _Pragma("unroll") for (int k = 0; k < 2; ++k) dst[m][k] = *(const PG8_LAS bf16x8*)(lds + PG8_SA(b, h) + aoff + m * 2048 + k * 1024); } while (0)
#define PG8_LDB(dst, b, h) do { _Pragma("unroll") for (int n = 0; n < 2; ++n) _Pragma("unroll") for (int k = 0; k < 2; ++k) dst[n][k] = *(const PG8_LAS bf16x8*)(lds + PG8_SB(b, h) + boff + n * 2048 + k * 1024); } while (0)
#define PG8_MMA(ai, bj, At, Bt) do { __builtin_amdgcn_s_setprio(1); _Pragma("unroll") for (int m = 0; m < 4; ++m) _Pragma("unroll") for (int n = 0; n < 2; ++n) _Pragma("unroll") for (int k = 0; k < 2; ++k) \
        acc[ai][bj][m][n] = __builtin_amdgcn_mfma_f32_16x16x32_bf16(Bt[n][k], At[m][k], acc[ai][bj][m][n], 0, 0, 0); __builtin_amdgcn_s_setprio(0); } while (0)
#define PG8_WAIT_V(n) asm volatile("s_waitcnt vmcnt(" #n ")" ::: "memory")
#define PG8_WAIT_L(n) asm volatile("s_waitcnt lgkmcnt(" #n ")" ::: "memory")
#define PG8_BAR __builtin_amdgcn_s_barrier()
#define PG8_SCHED __builtin_amdgcn_sched_barrier(0)
    Unit cur, nxt; int ui = 0;
    if (!S.next(0, cur)) return;
    f32x4 acc[2][2][4][2];
#pragma unroll
    for (int a = 0; a < 2; ++a)
#pragma unroll
        for (int b = 0; b < 2; ++b)
#pragma unroll
            for (int m = 0; m < 4; ++m)
#pragma unroll
                for (int n = 0; n < 2; ++n) acc[a][b][m][n] = (f32x4){0.f, 0.f, 0.f, 0.f};
    bf16x8 At[4][2], B0[2][2], B1[2][2];
    const char* cA = (const char*)g.A + (size_t)cur.pm * tstep; const char* cB = (const char*)g.Bt + (size_t)cur.pn * tstep;
    S.a_ready(cur);
    PG8_STAGE(PG8_SB(0, 0), cB, voffB); PG8_STAGE(PG8_SA(0, 0), cA, voffA); PG8_STAGE(PG8_SB(0, 1), cB + hstep, voffB); PG8_STAGE(PG8_SA(0, 1), cA + hstep, voffA);
    if (wr == 1) PG8_BAR;
    PG8_WAIT_V(4); PG8_BAR;
    PG8_STAGE(PG8_SB(1, 0), cB + kstep, voffB); PG8_STAGE(PG8_SA(1, 0), cA + kstep, voffA); PG8_STAGE(PG8_SB(1, 1), cB + hstep + kstep, voffB);
    PG8_WAIT_V(6); PG8_BAR;
    for (;;) {
        const bool has_next = S.next(ui + 1, nxt);
        const char* nA = has_next ? (const char*)g.A + (size_t)nxt.pm * tstep : cA; const char* nB = has_next ? (const char*)g.Bt + (size_t)nxt.pn * tstep : cB;
        for (int t = 0; t < nt; t += 2) {
            const bool last = (t == nt - 2);
            const char* a1 = cA + (size_t)(t + 1) * kstep;
            const char* a2 = last ? nA : cA + (size_t)(t + 2) * kstep; const char* b2 = last ? nB : cB + (size_t)(t + 2) * kstep;
            const char* a3 = a2 + kstep; const char* b3 = b2 + kstep;
            if (last && has_next) S.a_ready(nxt);
            PG8_LDB(B0, 0, 0); PG8_SCHED; PG8_LDA(At, 0, 0); PG8_STAGE(PG8_SA(1, 1), a1 + hstep, voffA);
            PG8_WAIT_L(8); PG8_BAR; PG8_WAIT_L(0); PG8_MMA(0, 0, At, B0); PG8_BAR; PG8_SCHED;
            PG8_LDB(B1, 0, 1); PG8_STAGE(PG8_SB(0, 0), b2, voffB);
            PG8_BAR; PG8_WAIT_L(0); PG8_MMA(0, 1, At, B1); PG8_BAR;
            PG8_LDA(At, 0, 1); PG8_STAGE(PG8_SA(0, 0), a2, voffA);
            PG8_BAR; PG8_WAIT_L(0); PG8_MMA(1, 0, At, B0); PG8_BAR; PG8_SCHED;
            PG8_STAGE(PG8_SB(0, 1), b2 + hstep, voffB);
            PG8_WAIT_V(6); PG8_BAR; PG8_MMA(1, 1, At, B1); PG8_BAR;
            PG8_LDB(B0, 1, 0); PG8_SCHED; PG8_LDA(At, 1, 0); PG8_STAGE(PG8_SA(0, 1), a2 + hstep, voffA);
            PG8_WAIT_L(8); PG8_BAR; PG8_WAIT_L(0); PG8_MMA(0, 0, At, B0); PG8_BAR; PG8_SCHED;
            PG8_LDB(B1, 1, 1); PG8_STAGE(PG8_SB(1, 0), b3, voffB);
            PG8_BAR; PG8_WAIT_L(0); PG8_MMA(0, 1, At, B1); PG8_BAR;
            PG8_LDA(At, 1, 1); PG8_STAGE(PG8_SA(1, 0), a3, voffA);
            PG8_BAR; PG8_WAIT_L(0); PG8_MMA(1, 0, At, B0); PG8_BAR; PG8_SCHED;
            PG8_STAGE(PG8_SB(1, 1), b3 + hstep, voffB);
            PG8_WAIT_V(6); PG8_BAR; PG8_MMA(1, 1, At, B1); PG8_BAR;
        }
        E(acc, cur, wr, wc, fr, fq); S.done(cur);
        if (!has_next) break;
#pragma unroll
        for (int a = 0; a < 2; ++a)
#pragma unroll
            for (int b = 0; b < 2; ++b)
#pragma unroll
                for (int m = 0; m < 4; ++m)
#pragma unroll
                    for (int n = 0; n < 2; ++n) acc[a][b][m][n] = (f32x4){0.f, 0.f, 0.f, 0.f};
        cur = nxt; cA = nA; cB = nB; ++ui;
    }
    PG8_WAIT_V(0);
    if (wr == 0) PG8_BAR;
    PG8_BAR;
#undef PG8_SA
#undef PG8_SB
#undef PG8_STAGE
#undef PG8_LDA
#undef PG8_LDB
#undef PG8_MMA
#undef PG8_WAIT_V
#undef PG8_WAIT_L
#undef PG8_BAR
#undef PG8_SCHED
}

struct EpiProj {
    static constexpr bool PERM = true, AFTER_DRAIN = false;
    bf16_t* proj; float* ab;
    __device__ __forceinline__ void operator()(const f32x4 (&acc)[2][2][4][2], const Unit& u, int wr, int wc, int fr, int fq) const {
        const int row0 = u.pm * BM + wr * 64 + fr;
        if (u.pn < 28) {
            const int col0 = u.pn * BM + wc * 32 + 8 * fq;
#pragma unroll
            for (int ai = 0; ai < 2; ++ai)
#pragma unroll
                for (int m = 0; m < 4; ++m) { bf16_t* rowp = proj + (size_t)(row0 + ai * HALF + m * 16) * NPROJ + col0;
#pragma unroll
                    for (int bj = 0; bj < 2; ++bj) { const f32x4 v0 = acc[ai][bj][m][0], v1 = acc[ai][bj][m][1];
                        u32x4 w; w.x = cvt_pk_bf16(v0[0], v0[1]); w.y = cvt_pk_bf16(v0[2], v0[3]); w.z = cvt_pk_bf16(v1[0], v1[1]); w.w = cvt_pk_bf16(v1[2], v1[3]);
                        *(u32x4*)(rowp + bj * HALF) = w; } }
        } else {
            const int c0 = wc * 32 + 8 * fq;
#pragma unroll
            for (int ai = 0; ai < 2; ++ai)
#pragma unroll
                for (int m = 0; m < 4; ++m) { float* rowp = ab + (size_t)(row0 + ai * HALF + m * 16) * NAB;
#pragma unroll
                    for (int n = 0; n < 2; ++n) { const int c = c0 + 4 * n; if (c < NAB) *(f32x4*)(rowp + c) = acc[ai][0][m][n]; } }
        }
    }
};
struct EpiRes {
    static constexpr bool PERM = false, AFTER_DRAIN = false;
    const float* xin_ctx; const float* xin_lat; float* xout; const float* gate;
    __device__ __forceinline__ void operator()(const f32x4 (&acc)[2][2][4][2], const Unit& u, int wr, int wc, int fr, int fq) const {
        const int row0 = u.pm * BM + wr * 64 + fr, col0 = u.pn * BM + wc * 32 + 4 * fq;
        const int mr = u.pm < 16 ? 0 : 1 + ((u.pm - 16) >> 3);
        const float* xin = u.pm < 16 ? xin_ctx : xin_lat;
        const float* g = gate + (size_t)mr * 6144 + col0;
        f32x4 gv[2][2];
#pragma unroll
        for (int bj = 0; bj < 2; ++bj)
#pragma unroll
            for (int n = 0; n < 2; ++n) gv[bj][n] = *(const f32x4*)(g + bj * HALF + n * 16);
#pragma unroll
        for (int ai = 0; ai < 2; ++ai)
#pragma unroll
            for (int m = 0; m < 4; ++m) { const size_t off = (size_t)(row0 + ai * HALF + m * 16) * D + col0;
#pragma unroll
                for (int bj = 0; bj < 2; ++bj)
#pragma unroll
                    for (int n = 0; n < 2; ++n) { const f32x4 xi = *(const f32x4*)(xin + off + bj * HALF + n * 16);
                        *(f32x4*)(xout + off + bj * HALF + n * 16) = xi + gv[bj][n] * acc[ai][bj][m][n]; } }
    }
};
}

__device__ void p0_prologue(const Args& a, unsigned char* lds, int bid, int nb, int wv) {
    const int tid = opaque_tid(wv);
    float* mod = (float*)(a.ws + WS_MOD);
    float* cs = (float*)lds;
    float* red = cs + 5 * 2048;
    for (int i = tid; i < 5 * 2048; i += NTHREADS) { const int r = i >> 11, k = i & 2047; const float cv = r == 0 ? a.c_ctx[k] : a.c[(r - 1) * 2048 + k]; cs[i] = silu_f(cv); }
    __syncthreads();
    const int c4 = tid & 15, kg = tid >> 4;
    for (int tile = bid; tile < 384; tile += nb) {
        const int l = tile / 96, n0 = (tile % 96) * 64;
        float acc[5][4];
#pragma unroll
        for (int r = 0; r < 5; ++r)
#pragma unroll
            for (int j = 0; j < 4; ++j) acc[r][j] = 0.f;
        const float* wp = a.w_mod + ((size_t)l * 2048 + kg * 64) * 6144 + n0 + c4 * 4;
#pragma unroll 4
        for (int kk = 0; kk < 64; ++kk) {
            const f32x4 w = *(const f32x4*)(wp + (size_t)kk * 6144);
#pragma unroll
            for (int r = 0; r < 5; ++r) { const float s = cs[r * 2048 + kg * 64 + kk];
#pragma unroll
                for (int j = 0; j < 4; ++j) acc[r][j] += s * w[j]; }
        }
#pragma unroll
        for (int r = 0; r < 5; ++r)
#pragma unroll
            for (int j = 0; j < 4; ++j) red[(kg * 5 + r) * 64 + c4 * 4 + j] = acc[r][j];
        __syncthreads();
        if (tid < 320) { const int r = tid >> 6, c = tid & 63; float s = 0.f;
            for (int g = 0; g < 32; ++g) s += red[(g * 5 + r) * 64 + c];
            mod[(size_t)(l * 5 + r) * 6144 + n0 + c] = s + a.b_mod[(size_t)l * 6144 + n0 + c]; }
        __syncthreads();
    }
}

__device__ void ph_wconv(const Args& a, int l, unsigned char* lds, int tb, int te, int bid, int nb, int wv) {
    const int tid = opaque_tid(wv);
    float* tl = (float*)lds;
    bf16_t* WinT = (bf16_t*)(a.ws + WS_WINT) + (size_t)(l & 1) * NPAD * D; bf16_t* WoutT = (bf16_t*)(a.ws + WS_WOUTT);
    for (int t = tb + bid; t < te; t += nb) {
        const float* src; bf16_t* dst; int ldn, nt, kt;
        if (t < 1856) { nt = t >> 4; kt = t & 15; src = a.w_in + (size_t)l * D * DIN; ldn = DIN; dst = WinT; }
        else { const int r = t - 1856; nt = r >> 4; kt = r & 15; src = a.w_out + (size_t)l * D * D; ldn = D; dst = WoutT; }
        const int n0 = nt * 64, k0 = kt * 128;
        for (int i = tid; i < 2048; i += NTHREADS) { const int kr = i >> 4, cc = (i & 15) * 4, n = n0 + cc;
            f32x4 v = (f32x4){0.f, 0.f, 0.f, 0.f};
            if (n < ldn) v = *(const f32x4*)(src + (size_t)(k0 + kr) * ldn + n);
            float* p = tl + kr * 65 + cc; p[0] = v[0]; p[1] = v[1]; p[2] = v[2]; p[3] = v[3]; }
        __syncthreads();
        for (int i = tid; i < 1024; i += NTHREADS) { const int kc = i & 15, n = i >> 4; const float* p = tl + (kc * 8) * 65 + n;
            u32x4 w; w.x = cvt_pk_bf16(p[0], p[65]); w.y = cvt_pk_bf16(p[130], p[195]); w.z = cvt_pk_bf16(p[260], p[325]); w.w = cvt_pk_bf16(p[390], p[455]);
            *(u32x4*)(dst + (size_t)(n0 + n) * D + k0 + kc * 8) = w; }
        __syncthreads();
    }
}

__device__ void ph_norm_mod(const float* xc, const float* xl, const float* nw, const float* modl, bf16_t* h, int bid, int nb, int wv) {
    const int tid = opaque_tid(wv), lane = tid & 63, wid = tid >> 6;
    for (int m = bid * 8 + wid; m < MTOK; m += nb * 8) {
        const float* xr = (m < NCTX ? xc : xl) + (size_t)m * D;
        const int mr = m < NCTX ? 0 : 1 + ((m - NCTX) >> 11);
        const float* sh = modl + (size_t)mr * 6144; const float* sc = sh + 2048;
        f32x4 v[8], w8[8], s8[8], h8[8]; float ss = 0.f;
#pragma unroll
        for (int j = 0; j < 8; ++j) { const int k = j * 256 + lane * 4; v[j] = *(const f32x4*)(xr + k); w8[j] = *(const f32x4*)(nw + k); s8[j] = *(const f32x4*)(sc + k); h8[j] = *(const f32x4*)(sh + k); }
        __builtin_amdgcn_sched_barrier(0);
#pragma unroll
        for (int j = 0; j < 8; ++j) ss += v[j][0] * v[j][0] + v[j][1] * v[j][1] + v[j][2] * v[j][2] + v[j][3] * v[j][3];
        ss = wave_sum(ss, lane);
        const float rstd = rsqrtf(ss * (1.0f / D) + EPS);
#pragma unroll
        for (int j = 0; j < 8; ++j) { const int k = j * 256 + lane * 4;
            const f32x4 w4 = w8[j], s4 = s8[j], h4 = h8[j];
            f32x4 y;
#pragma unroll
            for (int i = 0; i < 4; ++i) y[i] = v[j][i] * rstd * w4[i] * (1.0f + s4[i]) + h4[i];
            u32x2 w; w.x = cvt_pk_bf16(y[0], y[1]); w.y = cvt_pk_bf16(y[2], y[3]);
            *(u32x2*)(h + (size_t)m * D + k) = w; }
    }
}

__device__ void ph_final_norm(const float* x, const float* nw, float* out, int bid, int nb, int wv) {
    const int tid = opaque_tid(wv), lane = tid & 63, wid = tid >> 6;
    for (int m = bid * 8 + wid; m < MTOK; m += nb * 8) {
        const float* xr = x + (size_t)m * D;
        f32x4 v[8]; float ss = 0.f;
#pragma unroll
        for (int j = 0; j < 8; ++j) { v[j] = *(const f32x4*)(xr + j * 256 + lane * 4); ss += v[j][0] * v[j][0] + v[j][1] * v[j][1] + v[j][2] * v[j][2] + v[j][3] * v[j][3]; }
        ss = wave_sum(ss, lane);
        const float rstd = rsqrtf(ss * (1.0f / D) + EPS);
#pragma unroll
        for (int j = 0; j < 8; ++j) { const int k = j * 256 + lane * 4; const f32x4 w4 = *(const f32x4*)(nw + k);
            __builtin_nontemporal_store(v[j] * rstd * w4, (f32x4*)(out + (size_t)m * D + k)); }
    }
}

constexpr int L_KT = 0, L_QT = 17408, L_KTT = 34816, L_VTT = 53248, L_LF = 71680, L_LB = 89088, L_ATTS = 106496, L_WS1 = 124928, L_VEC = 142336;
constexpr int V_GF = 0, V_GB = 64, V_BF = 128, V_BB = 192, V_EGF = 256, V_EGB = 320, V_EDF = 384, V_EDB = 448, V_BGF = 512, V_BGB = 576;
static_assert(L_VEC + 640 * 4 <= LDS_BYTES, "LDS map");

__device__ __forceinline__ void build_frags(const unsigned char* src, int stride, int nKt, int nFr, const float* rowsc, const float* colsc, u32x4* dst, int t0, int nthr, bool swz = false) {
    for (int p = t0; p < nFr * 64; p += nthr) {
        const int lane = p & 63, f = p >> 6, s = f & 1, kt = (f >> 1) % nKt, mt = (f >> 1) / nKt, r = lane & 31, h = lane >> 5;
        const int row = 32 * mt + r, k0 = 32 * kt + 16 * s + 4 * h;
        const int sx = swz ? ((row >> 4) & 7) : 0;
        u32x2 lo = *(const u32x2*)(src + row * stride + (((k0 >> 3) ^ sx) << 4) + (k0 & 7) * 2), hi = *(const u32x2*)(src + row * stride + ((((k0 >> 3) + 1) ^ sx) << 4) + (k0 & 7) * 2);
        if (rowsc || colsc) {
            float v[8] = {bf_lo(lo.x), bf_hi(lo.x), bf_lo(lo.y), bf_hi(lo.y), bf_lo(hi.x), bf_hi(hi.x), bf_lo(hi.y), bf_hi(hi.y)};
            if (rowsc) { const float rs = rowsc[row];
#pragma unroll
                for (int i = 0; i < 8; ++i) v[i] *= rs; }
            if (colsc) { const f32x4 c0 = *(const f32x4*)(colsc + k0), c1 = *(const f32x4*)(colsc + k0 + 8);
#pragma unroll
                for (int i = 0; i < 4; ++i) { v[i] *= c0[i]; v[4 + i] *= c1[i]; } }
            lo.x = cvt_pk_bf16(v[0], v[1]); lo.y = cvt_pk_bf16(v[2], v[3]); hi.x = cvt_pk_bf16(v[4], v[5]); hi.y = cvt_pk_bf16(v[6], v[7]);
        }
        u32x4 w; w.x = lo.x; w.y = lo.y; w.z = hi.x; w.w = hi.y;
        __builtin_nontemporal_store(w, dst + p);
    }
}

template <int C, int S> __device__ __forceinline__ void tri_fma(const f32x4 (&cur)[16], float (&t)[64], float& a0, float& a1, float& a2, float& a3) {
    if constexpr (S < C) {
        const f32x4 l4 = cur[S / 4];
        a0 -= l4[0] * t[S];
        if constexpr (S + 1 < C) a1 -= l4[1] * t[S + 1];
        if constexpr (S + 2 < C) a2 -= l4[2] * t[S + 2];
        if constexpr (S + 3 < C) a3 -= l4[3] * t[S + 3];
        tri_fma<C, S + 4>(cur, t, a0, a1, a2, a3);
    }
}
template <int C, int S> __device__ __forceinline__ void tri_load(const float* Lr, f32x4 (&dst)[16]) {
    if constexpr (S < C) { dst[S / 4] = *(const f32x4*)(Lr + S); tri_load<C, S + 4>(Lr, dst); }
}
template <int C> __device__ __forceinline__ void tri_rows(const float* L, int j, float (&t)[64], const f32x4 (&cur)[16]) {
    if constexpr (C < 64) {
        f32x4 nxt[16];
        if constexpr (C + 1 < 64) tri_load<C + 1, 0>(L + (C + 1) * 68, nxt);
        __builtin_amdgcn_sched_barrier(0);
        float a0 = (C == j) ? 1.f : 0.f, a1 = 0.f, a2 = 0.f, a3 = 0.f;
        tri_fma<C, 0>(cur, t, a0, a1, a2, a3);
        t[C] = (a0 + a1) + (a2 + a3);
        tri_rows<C + 1>(L, j, t, nxt);
    }
}
__device__ __forceinline__ void tri_inverse(const float* L, int j, float (&t)[64]) { f32x4 r0[16]; tri_rows<0>(L, j, t, r0); }

__device__ __forceinline__ bf16x8 as_bf16x8(u32x4 w) { union { u32x4 u; bf16x8 b; } c; c.u = w; return c.b; }
__device__ __forceinline__ bf16x8 pack8(const f32x16& v, int o) {
    u32x4 w; w.x = cvt_pk_bf16(v[o], v[o + 1]); w.y = cvt_pk_bf16(v[o + 2], v[o + 3]); w.z = cvt_pk_bf16(v[o + 4], v[o + 5]); w.w = cvt_pk_bf16(v[o + 6], v[o + 7]); return as_bf16x8(w);
}
#define MFMA32(a, b, c) __builtin_amdgcn_mfma_f32_32x32x16_bf16((a), (b), (c), 0, 0, 0)

__device__ void ph_f12(const Args& a, int bid, int nb, int wv);
__device__ void ph_pre(const Args& a, int l, unsigned char* lds, int bid, int nb, int wv) {
    const bf16_t* proj = (const bf16_t*)(a.ws + WS_PROJ); const float* ab = (const float*)(a.ws + WS_AB);
    const float* cw = a.conv_w + (size_t)l * 3 * 4608;
    float* vec = (float*)(lds + L_VEC);
    float* EG = (float*)(a.ws + WS_EG);
    u32x4 xr[3][3][2]; f32x4 wr0[3][4];
#define PRE_ISSUE_X(itn, tidx) do { const int gcn = (itn) / NH, hdn = (itn) - gcn * NH; const int cn = (tidx) >> 3, ch0n = ((tidx) & 7) * 16, mn = gcn * 64 + cn; \
        int tn, lenn; if (mn < NCTX) { tn = mn & 255; lenn = 256; } else { tn = (mn - NCTX) & 2047; lenn = 2048; } const bool hpn = tn > 0, hnn = tn < lenn - 1; \
        _Pragma("unroll") for (int part = 0; part < 3; ++part) { const bf16_t* pn = proj + (size_t)mn * NPROJ + 1024 + part * DD + hdn * HD + ch0n; const u32x4 zz = (u32x4){0u, 0u, 0u, 0u}; \
            xr[part][1][0] = *(const u32x4*)pn; xr[part][1][1] = *(const u32x4*)(pn + 8); \
            if (hpn) { xr[part][0][0] = *(const u32x4*)(pn - NPROJ); xr[part][0][1] = *(const u32x4*)(pn - NPROJ + 8); } else { xr[part][0][0] = zz; xr[part][0][1] = zz; } \
            if (hnn) { xr[part][2][0] = *(const u32x4*)(pn + NPROJ); xr[part][2][1] = *(const u32x4*)(pn + NPROJ + 8); } else { xr[part][2][0] = zz; xr[part][2][1] = zz; } } \
        _Pragma("unroll") for (int tp = 0; tp < 3; ++tp) _Pragma("unroll") for (int q4 = 0; q4 < 4; ++q4) wr0[tp][q4] = *(const f32x4*)(cw + tp * 4608 + hdn * HD + ch0n + q4 * 4); } while (0)
    const int vb = (nb & 7) == 0 ? (bid & 7) * (nb >> 3) + (bid >> 3) : bid;
    { const int tid0 = opaque_tid(wv); PRE_ISSUE_X(vb, tid0); }
#pragma unroll 1
    for (int it = vb; it < 192 * NH; it += nb) {
        const int tid = opaque_tid(wv), lane = tid & 63, wid = tid >> 6, r = lane & 31, h = lane >> 5;
        const int gc = it / NH, hd = it - gc * NH;
        const int m0 = gc * 64;
        {
            const int c = tid >> 3, ch0 = (tid & 7) * 16;
            float y[3][16];
#pragma unroll
            for (int part = 0; part < 3; ++part) {
                const int col = part * DD + hd * HD + ch0;
                u32x4 x1[2], x0[2], x2[2];
                x0[0] = xr[part][0][0]; x0[1] = xr[part][0][1]; x1[0] = xr[part][1][0]; x1[1] = xr[part][1][1]; x2[0] = xr[part][2][0]; x2[1] = xr[part][2][1];
#pragma unroll
                for (int q4 = 0; q4 < 4; ++q4) {
                    const f32x4 w0 = part == 0 ? wr0[0][q4] : *(const f32x4*)(cw + col + q4 * 4), w1 = part == 0 ? wr0[1][q4] : *(const f32x4*)(cw + 4608 + col + q4 * 4), w2 = part == 0 ? wr0[2][q4] : *(const f32x4*)(cw + 2 * 4608 + col + q4 * 4);
                    const unsigned a0 = x0[q4 >> 1][(q4 & 1) * 2], a1 = x0[q4 >> 1][(q4 & 1) * 2 + 1];
                    const unsigned b0 = x1[q4 >> 1][(q4 & 1) * 2], b1 = x1[q4 >> 1][(q4 & 1) * 2 + 1];
                    const unsigned c0 = x2[q4 >> 1][(q4 & 1) * 2], c1 = x2[q4 >> 1][(q4 & 1) * 2 + 1];
                    y[part][q4 * 4 + 0] = silu_f(w0[0] * bf_lo(a0) + w1[0] * bf_lo(b0) + w2[0] * bf_lo(c0));
                    y[part][q4 * 4 + 1] = silu_f(w0[1] * bf_hi(a0) + w1[1] * bf_hi(b0) + w2[1] * bf_hi(c0));
                    y[part][q4 * 4 + 2] = silu_f(w0[2] * bf_lo(a1) + w1[2] * bf_lo(b1) + w2[2] * bf_lo(c1));
                    y[part][q4 * 4 + 3] = silu_f(w0[3] * bf_hi(a1) + w1[3] * bf_hi(b1) + w2[3] * bf_hi(c1));
                }
            }
            float sq = 0.f, sk = 0.f;
#pragma unroll
            for (int i = 0; i < 16; ++i) { sq += y[0][i] * y[0][i]; sk += y[1][i] * y[1][i]; }
            sq += lshfl(sq, lane ^ 1); sq += lshfl(sq, lane ^ 2); sq += lshfl(sq, lane ^ 4);
            sk += lshfl(sk, lane ^ 1); sk += lshfl(sk, lane ^ 2); sk += lshfl(sk, lane ^ 4);
            const float rq = rsqrtf(sq + EPS) * 0.08838834764831845f, rk = rsqrtf(sk + EPS);
            u32x4 wq[2], wk[2];
#pragma unroll
            for (int i = 0; i < 8; ++i) { wq[i >> 2][i & 3] = cvt_pk_bf16(y[0][2 * i] * rq, y[0][2 * i + 1] * rq); wk[i >> 2][i & 3] = cvt_pk_bf16(y[1][2 * i] * rk, y[1][2 * i + 1] * rk); }
            *(u32x4*)(lds + L_QT + c * 272 + ch0 * 2) = wq[0]; *(u32x4*)(lds + L_QT + c * 272 + ch0 * 2 + 16) = wq[1];
            *(u32x4*)(lds + L_KT + c * 272 + ch0 * 2) = wk[0]; *(u32x4*)(lds + L_KT + c * 272 + ch0 * 2 + 16) = wk[1];
#pragma unroll
            for (int i = 0; i < 8; ++i) {
                const int tsw = ((((c >> 3) ^ (tid & 7)) & 7) << 4) + (c & 7) * 2;
                const unsigned kk = wk[i >> 2][i & 3];
                *(bf16_t*)(lds + L_KTT + (ch0 + 2 * i) * 144 + tsw) = (bf16_t)(kk & 0xffffu);
                *(bf16_t*)(lds + L_KTT + (ch0 + 2 * i + 1) * 144 + tsw) = (bf16_t)(kk >> 16);
                const unsigned vv = cvt_pk_bf16(y[2][2 * i], y[2][2 * i + 1]);
                *(bf16_t*)(lds + L_VTT + (ch0 + 2 * i) * 144 + tsw) = (bf16_t)(vv & 0xffffu);
                *(bf16_t*)(lds + L_VTT + (ch0 + 2 * i + 1) * 144 + tsw) = (bf16_t)(vv >> 16);
            }
        }
        if (wid == 0) {
            const float* abr = ab + (size_t)(m0 + lane) * NAB;
            const float xf = abr[hd] + a.dt_bias[(l * 2 + 0) * NH + hd], xb = abr[NH + hd] + a.dt_bias[(l * 2 + 1) * NH + hd];
            const float lgf = -expf(a.a_log[(l * 2 + 0) * NH + hd]) * (fmaxf(xf, 0.f) + log1pf(expf(-fabsf(xf))));
            const float lgb = -expf(a.a_log[(l * 2 + 1) * NH + hd]) * (fmaxf(xb, 0.f) + log1pf(expf(-fabsf(xb))));
            const float bfw = 1.0f / (1.0f + expf(-abr[2 * NH + hd])), bbw = 1.0f / (1.0f + expf(-abr[3 * NH + hd]));
            float gf = lgf, gb = lgb;
#pragma unroll
            for (int o = 1; o < 64; o <<= 1) { const float uf = lshfl(gf, lane >= o ? lane - o : lane), ub = lshfl(gb, lane + o < 64 ? lane + o : lane); if (lane >= o) gf += uf; if (lane + o < 64) gb += ub; }
            const float glf = lshfl(gf, 63), glb = lshfl(gb, 0);
            const float egf = expf(gf), egb = expf(gb);
            vec[V_GF + lane] = gf; vec[V_GB + lane] = gb; vec[V_BF + lane] = bfw; vec[V_BB + lane] = bbw;
            vec[V_EGF + lane] = egf; vec[V_EGB + lane] = egb; vec[V_EDF + lane] = expf(glf - gf); vec[V_EDB + lane] = expf(glb - gb);
            vec[V_BGF + lane] = bfw * egf; vec[V_BGB + lane] = bbw * egb;
            if (lane < 2) EG[(size_t)(gc * NH + hd) * 2 + lane] = expf(lane == 0 ? glf : glb);
        }
        __syncthreads();
        {
            const int mat = wid >> 2, tile = wid & 3, mt = tile >> 1, nt = tile & 1;
            const unsigned char* As = lds + (mat == 0 ? L_KT : L_QT) + (32 * mt + r) * 272 + h * 16;
            const unsigned char* Bs = lds + L_KT + (32 * nt + r) * 272 + h * 16;
            f32x16 acc;
#pragma unroll
            for (int i = 0; i < 16; ++i) acc[i] = 0.f;
#pragma unroll
            for (int kh = 0; kh < 2; ++kh) { bf16x8 fa[4], fb[4];
#pragma unroll
                for (int k4 = 0; k4 < 4; ++k4) { fa[k4] = *(const bf16x8*)(As + (kh * 4 + k4) * 32); fb[k4] = *(const bf16x8*)(Bs + (kh * 4 + k4) * 32); }
#pragma unroll
                for (int k4 = 0; k4 < 4; ++k4) acc = MFMA32(fa[k4], fb[k4], acc); }
            const int s = 32 * nt + r;
            const float gfs = vec[V_GF + s], gbs = vec[V_GB + s];
            f32x4 gfc[4], gbc[4], bfc[4], bbc[4];
#pragma unroll
            for (int q = 0; q < 4; ++q) { const int c0 = 32 * mt + 8 * q + 4 * h;
                gfc[q] = *(const f32x4*)(vec + V_GF + c0); gbc[q] = *(const f32x4*)(vec + V_GB + c0); bfc[q] = *(const f32x4*)(vec + V_BF + c0); bbc[q] = *(const f32x4*)(vec + V_BB + c0); }
#pragma unroll
            for (int i = 0; i < 16; ++i) {
                const int c = 32 * mt + (i & 3) + 8 * (i >> 2) + 4 * h;
                const float df = __expf(fminf(gfc[i >> 2][i & 3] - gfs, 0.f)), db = __expf(fminf(gbc[i >> 2][i & 3] - gbs, 0.f));
                if (mat == 0) {
                    *(float*)(lds + L_LF + (c * 68 + s) * 4) = (c > s) ? bfc[i >> 2][i & 3] * acc[i] * df : 0.f;
                    *(float*)(lds + L_LB + ((63 - c) * 68 + (63 - s)) * 4) = (c < s) ? bbc[i >> 2][i & 3] * acc[i] * db : 0.f;
                } else {
                    *(bf16_t*)(lds + L_ATTS + c * 144 + s * 2) = (bf16_t)(cvt_pk_bf16((c >= s) ? acc[i] * df : 0.f, 0.f) & 0xffffu);
                    *(bf16_t*)(lds + L_ATTS + 9216 + c * 144 + s * 2) = (bf16_t)(cvt_pk_bf16((c <= s) ? acc[i] * db : 0.f, 0.f) & 0xffffu);
                }
            }
        }
        __syncthreads();
        unsigned char* sb0 = a.ws + WS_SCAN + (size_t)((gc * NH + hd) * 2) * SCAN_STRIDE;
        if (wid < 2) {
            float t[64];
            float* L = (float*)(lds + (wid == 0 ? L_LF : L_LB));
            tri_inverse(L, lane, t);
            float* Lw = wid == 0 ? L + lane : L + 63 * 68 + (63 - lane);
            const int rstep = wid == 0 ? 68 : -68;
#pragma unroll
            for (int c = 0; c < 64; ++c) Lw[c * rstep] = t[c];
            { const int itn = it + nb < 192 * NH ? it + nb : it; PRE_ISSUE_X(itn, tid); }
        } else {
            { const int itn = it + nb < 192 * NH ? it + nb : it; PRE_ISSUE_X(itn, tid); }
            const int t0 = tid - 128, nthr = NTHREADS - 128;
#pragma unroll 1
            for (int d = 0; d < 2; ++d) {
                unsigned char* sb = sb0 + (size_t)d * SCAN_STRIDE;
                build_frags(lds + L_QT, 272, 4, 16, vec + (d ? V_EGB : V_EGF), nullptr, (u32x4*)(sb + 16384), t0, nthr);
                build_frags(lds + L_KTT, 144, 2, 16, nullptr, vec + (d ? V_EDB : V_EDF), (u32x4*)(sb + 32768), t0, nthr, true);
                build_frags(lds + L_ATTS + d * 9216, 144, 2, 8, nullptr, nullptr, (u32x4*)(sb + 49152), t0, nthr);
            }
        }
        __syncthreads();
        {
            const int d = wid >> 2, nt = wid & 3;
            const float* T = (const float*)(lds + (d ? L_LB : L_LF));
            const float* bsc = vec + (d ? V_BB : V_BF); const float* gsc = vec + (d ? V_BGB : V_BGF);
            f32x16 aU[2], aW[2];
#pragma unroll
            for (int mt = 0; mt < 2; ++mt)
#pragma unroll
                for (int i = 0; i < 16; ++i) { aU[mt][i] = 0.f; aW[mt][i] = 0.f; }
#pragma unroll
            for (int ks = 0; ks < 4; ++ks) {
                const int k0 = 16 * ks + 8 * h;
                const int gsw = (((k0 >> 3) ^ ((32 * nt + r) >> 4)) & 7) << 4;
                const bf16x8 bv = *(const bf16x8*)(lds + L_VTT + (32 * nt + r) * 144 + gsw), bk = *(const bf16x8*)(lds + L_KTT + (32 * nt + r) * 144 + gsw);
                const f32x4 b0 = *(const f32x4*)(bsc + k0), b1 = *(const f32x4*)(bsc + k0 + 4), g0 = *(const f32x4*)(gsc + k0), g1 = *(const f32x4*)(gsc + k0 + 4);
#pragma unroll
                for (int mt = 0; mt < 2; ++mt) {
                    const float* Tr = T + (32 * mt + r) * 68 + k0;
                    const f32x4 t0 = *(const f32x4*)Tr, t1 = *(const f32x4*)(Tr + 4);
                    u32x4 wb, wg;
                    wb.x = cvt_pk_bf16(t0[0] * b0[0], t0[1] * b0[1]); wb.y = cvt_pk_bf16(t0[2] * b0[2], t0[3] * b0[3]); wb.z = cvt_pk_bf16(t1[0] * b1[0], t1[1] * b1[1]); wb.w = cvt_pk_bf16(t1[2] * b1[2], t1[3] * b1[3]);
                    wg.x = cvt_pk_bf16(-t0[0] * g0[0], -t0[1] * g0[1]); wg.y = cvt_pk_bf16(-t0[2] * g0[2], -t0[3] * g0[3]); wg.z = cvt_pk_bf16(-t1[0] * g1[0], -t1[1] * g1[1]); wg.w = cvt_pk_bf16(-t1[2] * g1[2], -t1[3] * g1[3]);
                    aU[mt] = MFMA32(as_bf16x8(wb), bv, aU[mt]);
                    aW[mt] = MFMA32(as_bf16x8(wg), bk, aW[mt]);
                }
            }
            unsigned char* sb = sb0 + (size_t)d * SCAN_STRIDE;
            unsigned char* stg = lds + (d ? L_WS1 : L_QT);
#pragma unroll
            for (int mt = 0; mt < 2; ++mt) {
#pragma unroll
                for (int hf = 0; hf < 2; ++hf) { u32x4 w;
                    w.x = cvt_pk_bf16(aU[mt][8 * hf + 0], aU[mt][8 * hf + 1]); w.y = cvt_pk_bf16(aU[mt][8 * hf + 2], aU[mt][8 * hf + 3]);
                    w.z = cvt_pk_bf16(aU[mt][8 * hf + 4], aU[mt][8 * hf + 5]); w.w = cvt_pk_bf16(aU[mt][8 * hf + 6], aU[mt][8 * hf + 7]);
                    __builtin_nontemporal_store(w, (u32x4*)(sb + 57344 + (size_t)((((mt * 4 + nt) * 2 + hf) * 64 + lane) * 16))); }
#pragma unroll
                for (int i = 0; i < 16; ++i) { const int c = 32 * mt + (i & 3) + 8 * (i >> 2) + 4 * h;
                    *(bf16_t*)(stg + c * 272 + (32 * nt + r) * 2) = (bf16_t)(cvt_pk_bf16(aW[mt][i], 0.f) & 0xffffu); }
            }
        }
        __syncthreads();
#pragma unroll 1
        for (int d = 0; d < 2; ++d) build_frags(lds + (d ? L_WS1 : L_QT), 272, 4, 16, nullptr, nullptr, (u32x4*)(sb0 + (size_t)d * SCAN_STRIDE), tid, NTHREADS);
        __syncthreads();
    }
    ph_f12(a, bid, nb, wv);
}

constexpr int FT1 = 0, FT2L = 4096, FT2C = 4096 + 2048, FT3 = 4096 + 2048 + 16384, FT_ENTRIES = 4096 + 2048 + 16384 + 256;
__device__ void ph_ftables(const Args& a, int bid, int nb, int wv) {
    const int tid = opaque_tid(wv);
    u32x4* tab = (u32x4*)(a.ws + WS_FT);
    for (int e = bid * NTHREADS + tid; e < FT_ENTRIES; e += nb * NTHREADS) {
        float v[8];
        if (e < FT2L) { const int lane = e & 63, ks = (e >> 6) & 7, cs = (e >> 9) & 1, nt = e >> 10, np = 32 * nt + (lane & 31), h = lane >> 5;
#pragma unroll
            for (int j = 0; j < 8; ++j) { const int k = 16 * ks + 8 * h + j, x = (k * np) & 127; v[j] = cs ? sinpif((float)x * (2.0f / 128.0f)) : cospif((float)x * (2.0f / 128.0f)); } }
        else if (e < FT2C) { const int e2 = e - FT2L, lane = e2 & 63, f = e2 >> 6, s = f & 1, kt = (f >> 1) & 3, mt = f >> 3, row = 32 * mt + (lane & 31), h = lane >> 5;
#pragma unroll
            for (int j = 0; j < 8; ++j) { const int k = 32 * kt + 16 * s + 8 * (j >> 2) + 4 * h + (j & 3), ri = row >> 6, wp = row & 63, pq = k >> 6, w = k & 63, x = (w * wp) & 63;
                const float c = cospif((float)x * (2.0f / 64.0f)), sn = sinpif((float)x * (2.0f / 64.0f));
                v[j] = ri == 0 ? (pq == 0 ? c : -sn) : (pq == 0 ? -sn : -c); } }
        else if (e < FT3) { const int e3 = e - FT2C, lane = e3 & 63, f = e3 >> 6, s = f & 1, kt = (f >> 1) & 15, mt = f >> 5, wp = 32 * mt + (lane & 31), h = lane >> 5;
#pragma unroll
            for (int j = 0; j < 8; ++j) { const int k = 32 * kt + 16 * s + 8 * (j >> 2) + 4 * h + (j & 3), pq = k >> 8, w = k & 255, x = (w * wp) & 255;
                v[j] = pq == 0 ? cospif((float)x * (2.0f / 256.0f)) : -sinpif((float)x * (2.0f / 256.0f)); } }
        else { const int e4 = e - FT3, lane = e4 & 63, ks = e4 >> 6, rp = lane & 31, h = lane >> 5;
#pragma unroll
            for (int j = 0; j < 8; ++j) { const int k = 16 * ks + 8 * h + j, ri = k >> 5, rr = k & 31, x = (rr * rp) & 31; v[j] = ri ? sinpif((float)x * (2.0f / 32.0f)) : cospif((float)x * (2.0f / 32.0f)); } }
        u32x4 w; w.x = cvt_pk_bf16(v[0], v[1]); w.y = cvt_pk_bf16(v[2], v[3]); w.z = cvt_pk_bf16(v[4], v[5]); w.w = cvt_pk_bf16(v[6], v[7]);
        tab[e] = w;
    }
}

__device__ __forceinline__ void f_stage1_s(const bf16_t* proj, const u32x4* tab, int m0, int g, int nt, int lane, f32x16 (&P)[2], f32x16 (&Q)[2]) {
    const int r = lane & 31, h = lane >> 5;
#pragma unroll
    for (int mt = 0; mt < 2; ++mt)
#pragma unroll
        for (int i = 0; i < 16; ++i) { P[mt][i] = 0.f; Q[mt][i] = 0.f; }
#pragma unroll
    for (int ks = 0; ks < 8; ++ks) {
        const bf16x8 bc = as_bf16x8(tab[FT1 + ((nt * 2 + 0) * 8 + ks) * 64 + lane]), bs = as_bf16x8(tab[FT1 + ((nt * 2 + 1) * 8 + ks) * 64 + lane]);
#pragma unroll
        for (int mt = 0; mt < 2; ++mt) {
            const bf16x8 av = *(const bf16x8*)(proj + (size_t)(m0 + 32 * mt + r) * NPROJ + g * 128 + 16 * ks + 8 * h);
            P[mt] = MFMA32(av, bc, P[mt]); Q[mt] = MFMA32(av, bs, Q[mt]);
        }
    }
}

__device__ __forceinline__ void f_stage1(const bf16_t* proj, const u32x4* tab, int m0, int g, int nt, int lane, f32x16 (&P)[2], f32x16 (&Q)[2]) {
    const int r = lane & 31, h = lane >> 5;
#pragma unroll
    for (int mt = 0; mt < 2; ++mt)
#pragma unroll
        for (int i = 0; i < 16; ++i) { P[mt][i] = 0.f; Q[mt][i] = 0.f; }
#pragma unroll
    for (int kb = 0; kb < 4; ++kb) {
        bf16x8 bc[2], bs[2], av[2][2];
#pragma unroll
        for (int k4 = 0; k4 < 2; ++k4) { const int ks = kb * 2 + k4;
            bc[k4] = as_bf16x8(tab[FT1 + ((nt * 2 + 0) * 8 + ks) * 64 + lane]); bs[k4] = as_bf16x8(tab[FT1 + ((nt * 2 + 1) * 8 + ks) * 64 + lane]);
#pragma unroll
            for (int mt = 0; mt < 2; ++mt) av[k4][mt] = *(const bf16x8*)(proj + (size_t)(m0 + 32 * mt + r) * NPROJ + g * 128 + 16 * ks + 8 * h); }
        __builtin_amdgcn_sched_barrier(0);
#pragma unroll
        for (int k4 = 0; k4 < 2; ++k4)
#pragma unroll
            for (int mt = 0; mt < 2; ++mt) { P[mt] = MFMA32(av[k4][mt], bc[k4], P[mt]); Q[mt] = MFMA32(av[k4][mt], bs[k4], Q[mt]); }
        __builtin_amdgcn_sched_barrier(0);
    }
}

__device__ void ph_f12(const Args& a, int bid, int nb, int wv) {
    const int tid = opaque_tid(wv), lane = tid & 63, wid = tid >> 6, r = lane & 31, h = lane >> 5;
    const bf16_t* proj = (const bf16_t*)(a.ws + WS_PROJ);
    const u32x4* tab = (const u32x4*)(a.ws + WS_FT);
    bf16_t* yf = (bf16_t*)(a.ws + WS_YF);
    bf16_t* Z = (bf16_t*)(a.ws + WS_Z);
    if (bid < 128) {
        const int b = bid >> 3, g = (bid >> 1) & 3, nt = wid & 3, mq = (bid & 1) * 2 + (wid >> 2);
        f32x16 ZR[2];
#pragma unroll
        for (int q = 0; q < 2; ++q)
#pragma unroll
            for (int i = 0; i < 16; ++i) ZR[q][i] = 0.f;
#pragma unroll 1
        for (int j = 0; j < 4; ++j) {
            f32x16 P[2], Q[2];
            f_stage1(proj, tab, b * 256 + j * 64, g, nt, lane, P, Q);
            bf16x8 Pb[2][2], Qb[2][2];
#pragma unroll
            for (int t = 0; t < 2; ++t) { Pb[t][0] = pack8(P[t], 0); Pb[t][1] = pack8(P[t], 8); Qb[t][0] = pack8(Q[t], 0); Qb[t][1] = pack8(Q[t], 8); }
#pragma unroll
            for (int q = 0; q < 2; ++q) { const int mt = 2 * mq + q;
                bf16x8 fp[4], fq[4];
#pragma unroll
                for (int ts = 0; ts < 4; ++ts) { fp[ts] = as_bf16x8(tab[FT2C + ((mt * 16 + 2 * j) * 2 + ts) * 64 + lane]); fq[ts] = as_bf16x8(tab[FT2C + ((mt * 16 + 8 + 2 * j) * 2 + ts) * 64 + lane]); }
                __builtin_amdgcn_sched_barrier(0);
#pragma unroll
                for (int ts = 0; ts < 4; ++ts) { ZR[q] = MFMA32(fp[ts], Pb[ts >> 1][ts & 1], ZR[q]); ZR[q] = MFMA32(fq[ts], Qb[ts >> 1][ts & 1], ZR[q]); }
                __builtin_amdgcn_sched_barrier(0);
            }
        }
        const float sc = 0.005524271728019903f;
#pragma unroll
        for (int q = 0; q < 2; ++q)
#pragma unroll
            for (int i = 0; i < 16; ++i) { const int wp = 32 * (2 * mq + q) + (i & 3) + 8 * (i >> 2) + 4 * h; const size_t m = (size_t)b * 256 + wp; const int col = g * 128 + 32 * nt + r;
                const float z = bf1(proj[m * NPROJ + 512 + col]);
                yf[m * DF + col] = (bf16_t)(cvt_pk_bf16(ZR[q][i] * sc * silu_f(z), 0.f) & 0xffffu); }
    } else {
#pragma unroll 1
        for (int item = (bid - 128) * 2 + (wid >> 2); item < 512; item += (nb - 128) * 2) {
            const int R = item >> 2, g = item & 3, nt = wid & 3, b = R >> 5, rr = R & 31;
            f32x16 P[2], Q[2];
            f_stage1_s(proj, tab, NCTX + R * 64, g, nt, lane, P, Q);
            bf16x8 Pb[2][2], Qb[2][2];
#pragma unroll
            for (int t = 0; t < 2; ++t) { Pb[t][0] = pack8(P[t], 0); Pb[t][1] = pack8(P[t], 8); Qb[t][0] = pack8(Q[t], 0); Qb[t][1] = pack8(Q[t], 8); }
#pragma unroll
            for (int mt = 0; mt < 4; ++mt) {
                f32x16 acc;
#pragma unroll
                for (int i = 0; i < 16; ++i) acc[i] = 0.f;
#pragma unroll
                for (int q8 = 0; q8 < 8; ++q8) acc = MFMA32(as_bf16x8(tab[FT2L + (mt * 8 + q8) * 64 + lane]), q8 < 4 ? Pb[q8 >> 1][q8 & 1] : Qb[(q8 >> 1) - 2][q8 & 1], acc);
                const int ri = mt >> 1;
#pragma unroll
                for (int i = 0; i < 16; ++i) { const int wp = 32 * (mt & 1) + (i & 3) + 8 * (i >> 2) + 4 * h;
                    Z[(((size_t)(b * 4 + g) * 64 + ri * 32 + rr) * 64 + wp) * 128 + 32 * nt + r] = (bf16_t)(cvt_pk_bf16(acc[i], 0.f) & 0xffffu); }
            }
        }
    }
}

__device__ __forceinline__ void f3_tile(const Args& a, int t, int lane) {
    const int r = lane & 31, h = lane >> 5;
    const bf16_t* proj = (const bf16_t*)(a.ws + WS_PROJ);
    const u32x4* tab = (const u32x4*)(a.ws + WS_FT);
    bf16_t* yf = (bf16_t*)(a.ws + WS_YF);
    const bf16_t* Z = (const bf16_t*)(a.ws + WS_Z);
    const int bg = t >> 6, b = bg >> 2, g = bg & 3, wp = t & 63;
    const float sc = 0.001953125f;
#pragma unroll 1
    for (int cb = 0; cb < 4; ++cb) {
        const int c0 = cb * 32;
        const bf16_t* zp = Z + (((size_t)bg * 64 + 8 * h) * 64 + wp) * 128 + c0 + r;
        f32x16 acc;
#pragma unroll
        for (int i = 0; i < 16; ++i) acc[i] = 0.f;
#pragma unroll
        for (int ks = 0; ks < 4; ++ks) {
            u32x4 w;
#pragma unroll
            for (int q = 0; q < 4; ++q) { const unsigned lo = zp[(size_t)(16 * ks + 2 * q) * 8192], hi = zp[(size_t)(16 * ks + 2 * q + 1) * 8192]; w[q] = lo | (hi << 16); }
            acc = MFMA32(as_bf16x8(tab[FT3 + ks * 64 + lane]), as_bf16x8(w), acc);
        }
#pragma unroll
        for (int i = 0; i < 16; ++i) { const int rp = (i & 3) + 8 * (i >> 2) + 4 * h; const size_t m = (size_t)NCTX + b * 2048 + rp * 64 + wp; const int col = g * 128 + c0 + r;
            const float z = bf1(proj[m * NPROJ + 512 + col]);
            yf[m * DF + col] = (bf16_t)(cvt_pk_bf16(acc[i] * sc * silu_f(z), 0.f) & 0xffffu); }
    }
}

__device__ void ph_rec(const Args& a, int l, unsigned char* lds_, int bid, int nb, int wv) {
    const int tid = opaque_tid(wv), lane = tid & 63, wid = __builtin_amdgcn_readfirstlane(tid >> 6), r = lane & 31, h = lane >> 5;
    PG8_LAS unsigned char* lds = (PG8_LAS unsigned char*)lds_;
    bf16_t* ob = (bf16_t*)(a.ws + WS_O);
    const float* EG = (const float*)(a.ws + WS_EG);
    float* state_new = a.out + (size_t)MTOK * D;
    const bool lat = bid < 96;
    const bool act = wid < 4;
    const int dvq = wid & 3;
#define REC_DMA(bp, buf) do { _Pragma("unroll") for (int q = 0; q < 14; ++q) __builtin_amdgcn_global_load_lds((const unsigned*)((bp) + (dvq * 14 + q) * 1024 + lane * 16), (PG8_LAS unsigned*)(lds + (buf) * 57344 + (dvq * 14 + q) * 1024), 16, 0, 0); } while (0)
#define REC_SYNC() do { asm volatile("s_waitcnt vmcnt(0) lgkmcnt(0)" ::: "memory"); __builtin_amdgcn_s_barrier(); asm volatile("" ::: "memory"); } while (0)
#define LFRAG(off) (*(const PG8_LAS bf16x8*)(gl + (off) + lane * 16))
#pragma unroll 1
    for (int cidx = lat ? bid : bid - 96; cidx < (lat ? 96 : 384); cidx += (lat ? 96 : nb - 96)) {
        const int b = cidx / 24, rem = cidx - b * 24, hd = rem >> 1, dir = rem & 1;
        const int gc0 = lat ? 64 + b * 32 : b * 4, nch = lat ? 32 : 4;
        const size_t soff = ((((size_t)b * DEPTH + l) * 2 + dir) * NH + hd) * (size_t)(HD * HD) + dvq * 32 + r;
        f32x16 S[4];
#pragma unroll
        for (int dt = 0; dt < 4; ++dt)
#pragma unroll
            for (int i = 0; i < 16; ++i) S[dt][i] = (lat && act) ? a.state_ctx[soff + (size_t)(32 * dt + (i & 3) + 8 * (i >> 2) + 4 * h) * HD] : 0.f;
        const int stepdir = dir ? -1 : 1;
        int gc = gc0 + (dir ? nch - 1 : 0);
        const unsigned char* base = a.ws + WS_SCAN + (size_t)((gc * NH + hd) * 2 + dir) * SCAN_STRIDE;
        const long bstep = (long)stepdir * (long)(NH * 2) * (long)SCAN_STRIDE;
        u32x4 un[2][2];
        float egl = 0.f;
        if (act) {
            REC_DMA(base, 0);
#pragma unroll
            for (int mt = 0; mt < 2; ++mt)
#pragma unroll
                for (int hf = 0; hf < 2; ++hf) un[mt][hf] = *((const u32x4*)(base + 57344) + ((mt * 4 + dvq) * 2 + hf) * 64 + lane);
            egl = EG[(gc * NH + hd) * 2 + dir];
        }
        REC_SYNC();
#pragma unroll 1
        for (int st = 0; st < nch; ++st) {
            const bool more = st + 1 < nch;
            const unsigned char* nbase = base + bstep;
            if (act) {
                PG8_LAS unsigned char* gl = lds + (st & 1) * 57344;
                f32x16 av[2], ao[2];
#pragma unroll
                for (int mt = 0; mt < 2; ++mt)
#pragma unroll
                    for (int hf = 0; hf < 2; ++hf) { const u32x4 u = un[mt][hf];
                        av[mt][8 * hf + 0] = bf_lo(u.x); av[mt][8 * hf + 1] = bf_hi(u.x); av[mt][8 * hf + 2] = bf_lo(u.y); av[mt][8 * hf + 3] = bf_hi(u.y);
                        av[mt][8 * hf + 4] = bf_lo(u.z); av[mt][8 * hf + 5] = bf_hi(u.z); av[mt][8 * hf + 6] = bf_lo(u.w); av[mt][8 * hf + 7] = bf_hi(u.w); }
                const float egc = egl;
                if (more) { REC_DMA(nbase, (st + 1) & 1);
#pragma unroll
                    for (int mt = 0; mt < 2; ++mt)
#pragma unroll
                        for (int hf = 0; hf < 2; ++hf) un[mt][hf] = *((const u32x4*)(nbase + 57344) + ((mt * 4 + dvq) * 2 + hf) * 64 + lane);
                    egl = EG[((gc + stepdir) * NH + hd) * 2 + dir]; }
                bf16x8 Sb[4][2];
#pragma unroll
                for (int dt = 0; dt < 4; ++dt) { Sb[dt][0] = pack8(S[dt], 0); Sb[dt][1] = pack8(S[dt], 8); }
#pragma unroll
                for (int mt = 0; mt < 2; ++mt) {
                    bf16x8 fr[8];
#pragma unroll
                    for (int q = 0; q < 8; ++q) fr[q] = LFRAG((mt * 8 + q) * 1024);
                    __builtin_amdgcn_sched_barrier(0);
#pragma unroll
                    for (int q = 0; q < 8; ++q) av[mt] = MFMA32(fr[q], Sb[q >> 1][q & 1], av[mt]);
                    __builtin_amdgcn_sched_barrier(0);
                }
#pragma unroll
                for (int mt = 0; mt < 2; ++mt) {
#pragma unroll
                    for (int i = 0; i < 16; ++i) ao[mt][i] = 0.f;
                    bf16x8 fr[8];
#pragma unroll
                    for (int q = 0; q < 8; ++q) fr[q] = LFRAG(16384 + (mt * 8 + q) * 1024);
                    __builtin_amdgcn_sched_barrier(0);
#pragma unroll
                    for (int q = 0; q < 8; ++q) ao[mt] = MFMA32(fr[q], Sb[q >> 1][q & 1], ao[mt]);
                    __builtin_amdgcn_sched_barrier(0);
                }
                bf16x8 Vb[2][2];
#pragma unroll
                for (int tt = 0; tt < 2; ++tt) { Vb[tt][0] = pack8(av[tt], 0); Vb[tt][1] = pack8(av[tt], 8); }
                {
                    bf16x8 fr[8];
#pragma unroll
                    for (int q = 0; q < 8; ++q) fr[q] = LFRAG(32768 + 16384 + q * 1024);
#pragma unroll
                    for (int q = 0; q < 8; ++q) ao[q >> 2] = MFMA32(fr[q], Vb[(q >> 1) & 1][q & 1], ao[q >> 2]);
                }
#pragma unroll
                for (int dh = 0; dh < 2; ++dh) {
                    bf16x8 fr[8];
#pragma unroll
                    for (int q = 0; q < 8; ++q) fr[q] = LFRAG(32768 + (dh * 8 + q) * 1024);
#pragma unroll
                    for (int i = 0; i < 16; ++i) { S[2 * dh][i] *= egc; S[2 * dh + 1][i] *= egc; }
#pragma unroll
                    for (int q = 0; q < 8; ++q) S[2 * dh + (q >> 2)] = MFMA32(fr[q], Vb[(q >> 1) & 1][q & 1], S[2 * dh + (q >> 2)]);
                }
                bf16_t* op = ob + ((size_t)dir * MTOK + (size_t)gc * 64) * DD + hd * HD + dvq * 32 + r;
#pragma unroll
                for (int mt = 0; mt < 2; ++mt)
#pragma unroll
                    for (int i = 0; i < 16; ++i) op[(size_t)(32 * mt + (i & 3) + 8 * (i >> 2) + 4 * h) * DD] = (bf16_t)(cvt_pk_bf16(ao[mt][i], 0.f) & 0xffffu);
            }
            REC_SYNC();
            base = nbase; gc += stepdir;
        }
        if (!lat && act) {
#pragma unroll
            for (int dt = 0; dt < 4; ++dt)
#pragma unroll
                for (int i = 0; i < 16; ++i) __builtin_nontemporal_store(S[dt][i], state_new + soff + (size_t)(32 * dt + (i & 3) + 8 * (i >> 2) + 4 * h) * HD);
        }
    }
#undef REC_DMA
#undef REC_SYNC
#undef LFRAG
    if (bid >= 96) {
        const int nl = (bid - 96) * 8 + wid, nnl = (nb - 96) * 8;
#pragma unroll 1
        for (int t = nl; t < 1024; t += nnl) f3_tile(a, t, lane);
    }
}

__device__ void ph_d(const Args& a, int l, unsigned char* lds, int bid, int nb, int wv) {
    const int tid = opaque_tid(wv), lane = tid & 63, wid = tid >> 6;
    const bf16_t* proj = (const bf16_t*)(a.ws + WS_PROJ);
    bf16_t* ycat = (bf16_t*)(a.ws + WS_H);
    const bf16_t* ob = (const bf16_t*)(a.ws + WS_O);
    const bf16_t* yf = (const bf16_t*)(a.ws + WS_YF);
    const float* gnw = a.gnorm_w + l * HD + (lane & 15) * 8;
#pragma unroll 1
    for (int it = bid * 8 + wid; it < MTOK * 3; it += nb * 8) {
        const int m = it / 3, j = it - m * 3;
        const size_t o = (size_t)m * DD + j * 512 + lane * 8;
        const u32x4 fa = *(const u32x4*)(ob + o), fb = *(const u32x4*)(ob + (size_t)MTOK * DD + o), zz = *(const u32x4*)(proj + (size_t)m * NPROJ + 5632 + j * 512 + lane * 8);
        if (j == 0) *(u32x4*)(ycat + (size_t)m * D + lane * 8) = *(const u32x4*)(yf + (size_t)m * DF + lane * 8);
        const f32x4 g0 = *(const f32x4*)gnw, g1 = *(const f32x4*)(gnw + 4);
        const float gw8[8] = {g0[0], g0[1], g0[2], g0[3], g1[0], g1[1], g1[2], g1[3]};
        float v[8], z[8]; float ss = 0.f;
#pragma unroll
        for (int q = 0; q < 4; ++q) { v[2 * q] = bf_lo(fa[q]) + bf_lo(fb[q]); v[2 * q + 1] = bf_hi(fa[q]) + bf_hi(fb[q]); z[2 * q] = bf_lo(zz[q]); z[2 * q + 1] = bf_hi(zz[q]); }
#pragma unroll
        for (int q = 0; q < 8; ++q) ss += v[q] * v[q];
        ss += lshfl(ss, lane ^ 1); ss += lshfl(ss, lane ^ 2); ss += lshfl(ss, lane ^ 4); ss += lshfl(ss, lane ^ 8);
        const float rstd = rsqrtf(ss * (1.0f / HD) + EPS);
        u32x4 w;
#pragma unroll
        for (int q = 0; q < 4; ++q) w[q] = cvt_pk_bf16(v[2 * q] * rstd * gw8[2 * q] * silu_f(z[2 * q]), v[2 * q + 1] * rstd * gw8[2 * q + 1] * silu_f(z[2 * q + 1]));
        *(u32x4*)(ycat + (size_t)m * D + DF + j * 512 + lane * 8) = w;
    }
}

#define XB_TMO      128
#define XB_XCNT(j)  (256  + 64 * (j))
#define XB_XSUB(j)  (1280 + 64 * (j))
#define XB_XGEN(j)  (2304 + 64 * (j))
#define XB_TOP      3328
#define XB_TOPGEN   3392
#define XCD_BAR_WORDS 3456
#define XB_SPIN_CAP (1u << 20)
__device__ __forceinline__ unsigned xb_ld(unsigned* p)              { return __hip_atomic_load(p, __ATOMIC_RELAXED, __HIP_MEMORY_SCOPE_AGENT); }
__device__ __forceinline__ unsigned xb_add(unsigned* p, unsigned v) { return __hip_atomic_fetch_add(p, v, __ATOMIC_RELAXED, __HIP_MEMORY_SCOPE_AGENT); }
__device__ __forceinline__ unsigned xb_xcc_id() { return (unsigned)__builtin_amdgcn_s_getreg((3 << 11) | 20) & 0xFu; }
#define XB_SPIN(cond, bar) do { unsigned _sp = 0; while (cond) { __builtin_amdgcn_s_sleep(1); \
    if ((++_sp & 255u) == 0u) { if (xb_ld(&(bar)[XB_TMO])) break; if (_sp > XB_SPIN_CAP) { atomicAdd(&(bar)[XB_TMO], 1u); break; } } } } while (0)
struct XcdBarrier { unsigned* bar; unsigned x; volatile PG8_LAS unsigned* st; };
__device__ __forceinline__ XcdBarrier xcd_barrier_post(unsigned* bar, volatile PG8_LAS unsigned* st) {
    XcdBarrier b; b.bar = bar; b.x = xb_xcc_id(); b.st = st;
    if (threadIdx.x == 0) (void)xb_add(&bar[XB_XCNT(b.x)], 1u);
    return b;
}
__device__ __forceinline__ void xcd_barrier_complete(unsigned* bar, unsigned x, unsigned& nloc, unsigned& nx) {
    const unsigned G = gridDim.x * gridDim.y * gridDim.z;
    unsigned sum, cnt, mine, sp = 0u;
    for (;;) {
        sum = 0u; cnt = 0u; mine = 0u;
#pragma unroll
        for (unsigned j = 0; j < 16; ++j) { const unsigned c = xb_ld(&bar[XB_XCNT(j)]); sum += c; cnt += (c > 0u) ? 1u : 0u; mine = (j == x) ? c : mine; }
        if (sum == G) break;
        __builtin_amdgcn_s_sleep(1);
        if ((++sp & 255u) == 0u) { if (xb_ld(&bar[XB_TMO])) break; if (sp > XB_SPIN_CAP) { atomicAdd(&bar[XB_TMO], 1u); break; } }
    }
    nloc = mine > 0u ? mine : 1u; nx = cnt > 0u ? cnt : 1u;
}
__device__ __forceinline__ void xcd_barrier(const XcdBarrier& b) {
    asm volatile("s_waitcnt vmcnt(0)" ::: "memory");
    __syncthreads();
    if (threadIdx.x == 0) {
        unsigned* bar = b.bar;
        __builtin_amdgcn_s_waitcnt(0);
        unsigned nloc = b.st[0], nx = b.st[1];
        if (nloc == 0u) { xcd_barrier_complete(bar, b.x, nloc, nx); b.st[0] = nloc; b.st[1] = nx; }
        const unsigned old = xb_add(&bar[XB_XSUB(b.x)], 1u);
        const unsigned gen = old / nloc;
        if (old + 1u == (gen + 1u) * nloc) {
            __builtin_amdgcn_fence(__ATOMIC_RELEASE, "agent");
            asm volatile("s_waitcnt vmcnt(0)" ::: "memory");
            const unsigned og = xb_add(&bar[XB_TOP], 1u);
            const unsigned tg = og / nx;
            if (og + 1u == (tg + 1u) * nx) xb_add(&bar[XB_TOPGEN], 1u);
            else XB_SPIN(xb_ld(&bar[XB_TOPGEN]) == tg, bar);
            __builtin_amdgcn_fence(__ATOMIC_ACQUIRE, "agent");
            xb_add(&bar[XB_XGEN(b.x)], 1u);
            asm volatile("s_waitcnt vmcnt(0)" ::: "memory");
        } else {
            XB_SPIN(xb_ld(&bar[XB_XGEN(b.x)]) == gen, bar);
            __builtin_amdgcn_fence(__ATOMIC_ACQUIRE, "agent");
            asm volatile("s_waitcnt vmcnt(0)" ::: "memory");
        }
    }
    __syncthreads();
}

constexpr int NPH = 1 + DEPTH * 6 + 1;
constexpr int WCONV_EARLY = 1152;
__global__ void __launch_bounds__(NTHREADS, 2) mk_fwd(Args a) {
    const int ph_lo = a.ph_lo, ph_hi = a.ph_hi;
    const int wv = __builtin_amdgcn_readfirstlane((int)(threadIdx.x >> 6));
    unsigned char* const ws0 = a.ws;
    extern __shared__ __attribute__((aligned(16))) unsigned char shm[];
    cg::grid_group grid = cg::this_grid();
    const int bid = blockIdx.x, nb = gridDim.x;
    volatile PG8_LAS unsigned* bst = (volatile PG8_LAS unsigned*)((PG8_LAS unsigned char*)shm + LDS_BYTES - 16);
    XcdBarrier xb; xb.bar = (unsigned*)(ws0 + WS_BAR); xb.x = 0; xb.st = bst;
    if (ph_hi - ph_lo > 1) {
        if (threadIdx.x == 0) { bst[0] = 0u; bst[1] = 0u; }
        __syncthreads();
        xb = xcd_barrier_post((unsigned*)(ws0 + WS_BAR), bst);
    }
    for (int ph = ph_lo; ph < ph_hi; ++ph) {
        float* xws = (float*)(a.ws + WS_X);
        bf16_t* hb = (bf16_t*)(a.ws + WS_H);
        const float* mod = (const float*)(a.ws + WS_MOD);
        if (ph == 0) { p0_prologue(a, shm, bid, nb, wv); ph_ftables(a, bid, nb, wv); }
        else if (ph == NPH - 1) ph_final_norm(xws, a.final_norm_w, a.out, bid, nb, wv);
        else {
            const int l = (ph - 1) / 6, sub = (ph - 1) % 6;
            const float* xc = l == 0 ? a.x_prompt : xws; const float* xl = l == 0 ? a.x_sample - (size_t)NCTX * D : xws;
            const float* modl = mod + (size_t)l * 5 * 6144;
            if (sub == 0) { ph_norm_mod(xc, xl, a.norm_w + (size_t)l * D, modl, hb, bid, nb, wv); if (nb != 256) ph_wconv(a, l, shm, 0, 1856 + 512, bid, nb, wv); else if (l == 0) ph_wconv(a, 0, shm, 0, 1856, bid, nb, wv); }
            else if (sub == 1) {
                pg8::Gemm g{hb, (const bf16_t*)(a.ws + WS_WINT) + (size_t)(l & 1) * NPAD * D, MTOK, NPAD, D}; pg8::StaticOrder S; S.init(MTOK, NPAD, nb, bid);
                pg8::EpiProj E{(bf16_t*)(a.ws + WS_PROJ), (float*)(a.ws + WS_AB)};
                pg8::gemm_phase<pg8::EpiProj, pg8::StaticOrder>((PG8_LAS unsigned char*)shm, g, S, E, wv);
                if (nb == 256 && bid >= 112) { __syncthreads(); ph_wconv(a, l, shm, 1856, 1856 + 512, bid - 112, 144, wv); if (l + 1 < DEPTH) ph_wconv(a, l + 1, shm, WCONV_EARLY, 1856, bid - 112, 144, wv); }
            }
            else if (sub == 2) ph_pre(a, l, shm, bid, nb, wv);
            else if (sub == 3) ph_rec(a, l, shm, bid, nb, wv);
            else if (sub == 4) ph_d(a, l, shm, bid, nb, wv);
            else {
                pg8::Gemm g{hb, (const bf16_t*)(a.ws + WS_WOUTT), MTOK, D, D}; pg8::StaticOrder S; S.init(MTOK, D, nb, bid);
                pg8::EpiRes E{xc, xl, xws, modl + 4096};
                pg8::gemm_phase<pg8::EpiRes, pg8::StaticOrder>((PG8_LAS unsigned char*)shm, g, S, E, wv);
                if (l + 1 < DEPTH && nb == 256 && bid >= 128) { __syncthreads(); ph_wconv(a, l + 1, shm, 0, WCONV_EARLY, bid - 128, 128, wv); }
            }
        }
        if (ph + 1 < ph_hi) { if (ph == 0) grid.sync(); else xcd_barrier(xb); }
    }
}

extern "C" void kernel_launch(void* const* d_in, const int* in_sizes, int n_in, void* d_out, int out_size, void* d_ws, size_t ws_size, hipStream_t stream) {
    static int grid = 0;
    if (grid == 0) {
        if (ws_size < WS_END) { fprintf(stderr, "kernel_launch: workspace too small: %zu < %zu\n", ws_size, (size_t)WS_END); grid = -1; return; }
        int dev = 0, cus = 0;
        (void)hipGetDevice(&dev); (void)hipDeviceGetAttribute(&cus, hipDeviceAttributeMultiprocessorCount, dev);
        if (hipFuncSetAttribute((const void*)mk_fwd, hipFuncAttributeMaxDynamicSharedMemorySize, LDS_BYTES) != hipSuccess) { fprintf(stderr, "kernel_launch: hipFuncSetAttribute failed\n"); grid = -1; return; }
        int per_cu = 0;
        if (hipOccupancyMaxActiveBlocksPerMultiprocessor(&per_cu, (const void*)mk_fwd, NTHREADS, LDS_BYTES) != hipSuccess || per_cu < 1) { fprintf(stderr, "kernel_launch: occupancy query says %d\n", per_cu); }
        (void)hipGetLastError();
        grid = cus > 0 ? cus : 256;
    }
    if (grid < 0) return;
    Args a{};
    a.x_prompt = (const float*)d_in[0]; a.x_sample = (const float*)d_in[1]; a.state_ctx = (const float*)d_in[2]; a.c = (const float*)d_in[3]; a.c_ctx = (const float*)d_in[4];
    a.norm_w = (const float*)d_in[5]; a.w_mod = (const float*)d_in[6]; a.b_mod = (const float*)d_in[7]; a.w_in = (const float*)d_in[8]; a.conv_w = (const float*)d_in[9];
    a.a_log = (const float*)d_in[10]; a.dt_bias = (const float*)d_in[11]; a.gnorm_w = (const float*)d_in[12]; a.w_out = (const float*)d_in[13]; a.final_norm_w = (const float*)d_in[14];
    a.out = (float*)d_out; a.ws = (unsigned char*)d_ws;
#if ONE_LAUNCH
    (void)hipMemsetAsync((char*)d_ws + WS_BAR, 0, 16384, stream);
    a.ph_lo = 0; a.ph_hi = NPH;
    void* args[] = {&a};
    hipError_t e = hipLaunchCooperativeKernel((const void*)mk_fwd, dim3(grid), dim3(NTHREADS), args, LDS_BYTES, stream);
    if (e != hipSuccess) fprintf(stderr, "cooperative launch failed: %s (grid %d)\n", hipGetErrorString(e), grid);
#else
    for (int ph = 0; ph < NPH; ++ph) { a.ph_lo = ph; a.ph_hi = ph + 1; hipLaunchKernelGGL(mk_fwd, dim3(grid), dim3(NTHREADS), LDS_BYTES, stream, a); }
#endif
}
```
